# Optimizing an MI355X kernel written in HIP

```python
import jax, jax.numpy as jnp
from jax import lax
import numpy as np

D_MODEL = 2048
BATCH = 4
SEQ = 2048
DEPTH = 4
DEC_BATCH = 8
DEC_SEQ = 1
PAST_LEN = 16384
PAGE_SIZE = 128

HEAD_DIM = 128
HEADS_PER_GROUP = D_MODEL // HEAD_DIM
DILATION_PAIRS = ((128, 1), (512, 4), (2048, 16))
N_GROUPS = len(DILATION_PAIRS)
N_SUBHEADS = N_GROUPS * HEADS_PER_GROUP
ATT_WIDTH = HEADS_PER_GROUP * HEAD_DIM
QKV_WIDTH = N_GROUPS * ATT_WIDTH
ATT_IN_COLS = 3 * QKV_WIDTH + ATT_WIDTH
BAND = 128
ATT_SCALE = HEAD_DIM ** -0.5
POOL_WINDOWS = (2, 4, 8, 16)
POOL_WIDTH = 2 * D_MODEL
POOL_GROUP = POOL_WIDTH // len(POOL_WINDOWS)
POOL_BUF = max(POOL_WINDOWS) - 1
N_BUCKETS = 32
T5_MAX_DIST = 2048
N_POOL_LAYERS = (DEPTH + 1) // 2
N_ATT_LAYERS = DEPTH // 2
RMS_EPS = 1e-6
NEG_INF = -1e30

kernel_name = "hybrid_pool_dilated_attn_decoder_step"


def rmsnorm(x, g):
    xf = x.astype(jnp.float32)
    y = xf * lax.rsqrt(jnp.mean(xf * xf, axis=-1, keepdims=True) + RMS_EPS)
    return (y * g.astype(jnp.float32)).astype(x.dtype)


def adaln(c, w, b):
    mod = jax.nn.silu(c) @ w + b
    shift, scale, gate = jnp.split(mod, 3, axis=-1)
    return shift[:, None, :], scale[:, None, :], gate[:, None, :]


def t5_bucket(dist):
    dist = np.asarray(dist, dtype=np.int64)
    max_exact = N_BUCKETS // 2
    ratio = np.log(np.maximum(dist, 1) / max_exact) / np.log(T5_MAX_DIST / max_exact)
    large = np.minimum(max_exact + (ratio * (N_BUCKETS - max_exact)).astype(np.int64), N_BUCKETS - 1)
    return np.where(dist < max_exact, dist, large).astype(np.int32)


def pool_mix(u_ext, n_prev, start_pos, w_grp, scale):
    B, T, E = u_ext.shape
    S = T - n_prev
    uf = u_ext.astype(jnp.float32)
    cs = jnp.concatenate([jnp.zeros((B, 1, E), jnp.float32), jnp.cumsum(uf, axis=1)], axis=1)
    j = np.arange(n_prev, T)
    pos = start_pos + np.arange(S)
    res = []
    for g, w in enumerate(POOL_WINDOWS):
        sl = slice(g * POOL_GROUP, (g + 1) * POOL_GROUP)
        lo = np.maximum(j + 1 - w, 0)
        cnt = np.minimum(w, pos + 1).astype(np.float32)
        csg = cs[:, :, sl]
        res.append((csg[:, j + 1] - csg[:, lo]) / cnt[None, :, None] - uf[:, n_prev:, sl])
    r = jnp.stack(res, axis=2)
    y = jnp.einsum('bsge,gef->bsgf', r, w_grp.astype(jnp.float32)).reshape(B, S, E)
    return (y * scale.astype(jnp.float32)).astype(u_ext.dtype)


def pool_layer(h, buf, w_in, w_grp, scale, w_out):
    proj = h @ w_in
    u, z = proj[..., :POOL_WIDTH], proj[..., POOL_WIDTH:]
    if buf is None:
        u_ext, n_prev, start = u, 0, 0
    else:
        u_ext = jnp.concatenate([buf.astype(u.dtype), u], axis=1)
        n_prev, start = buf.shape[1], PAST_LEN
    r = pool_mix(u_ext, n_prev, start, w_grp, scale)
    y = (r * jax.nn.silu(z)) @ w_out
    return y, u_ext[:, -POOL_BUF:]


def dilated_prompt(q, k, v, dil, tab):
    B, S, H, dh = q.shape
    n = S // dil
    nb = -(-n // BAND)
    pad = nb * BAND - n

    def sub(x):
        x = x.reshape(B, n, dil, H, dh).transpose(0, 2, 1, 3, 4)
        x = jnp.pad(x, ((0, 0), (0, 0), (0, pad), (0, 0), (0, 0)))
        return x.reshape(B, dil, nb, BAND, H, dh)

    def band(x):
        prev = jnp.pad(x, ((0, 0), (0, 0), (1, 0), (0, 0), (0, 0), (0, 0)))[:, :, :-1]
        return jnp.concatenate([prev, x], axis=3)

    qs = sub(q)
    kb, vb = band(sub(k)), band(sub(v))
    rel = np.arange(BAND)[:, None] + BAND - np.arange(2 * BAND)[None, :]
    inband = (rel >= 0) & (rel <= BAND)
    valid = inband[None] & ((np.arange(nb)[:, None, None] > 0) | (np.arange(2 * BAND)[None, None, :] >= BAND))
    bias = tab[t5_bucket(np.clip(rel, 0, BAND) * dil)].astype(jnp.float32).transpose(2, 0, 1)
    s = jnp.einsum('brcqhe,brckhe->brchqk', qs, kb).astype(jnp.float32) * ATT_SCALE + bias
    s = jnp.where(valid[:, None], s, NEG_INF)
    m = jnp.max(s, axis=-1, keepdims=True)
    p = jnp.exp(s - m)
    l = jnp.sum(p, axis=-1, keepdims=True)
    o = jnp.einsum('brchqk,brckhe->brcqhe', p / l, vb.astype(jnp.float32))
    lse = jnp.swapaxes((m + jnp.log(l))[..., 0], 3, 4)
    o = o.reshape(B, dil, nb * BAND, H, dh)[:, :, :n].transpose(0, 2, 1, 3, 4).reshape(B, S, H, dh)
    lse = lse.reshape(B, dil, nb * BAND, H)[:, :, :n].transpose(0, 2, 1, 3).reshape(B, S, H)
    return o, lse


def dilated_sample(q, k_ext, v_ext, n_buf, dil, tab):
    B, S, H, dh = q.shape
    offs = np.arange(BAND + 1)
    idx = n_buf + np.arange(S)[:, None] - offs[None, :] * dil
    valid = idx >= 0
    idx = np.maximum(idx, 0)
    kg, vg = k_ext[:, idx], v_ext[:, idx]
    bias = tab[t5_bucket(offs * dil)].astype(jnp.float32).T
    s = jnp.einsum('bshe,bskhe->bhsk', q, kg).astype(jnp.float32) * ATT_SCALE + bias[None, :, None, :]
    s = jnp.where(valid[None, None], s, NEG_INF)
    m = jnp.max(s, axis=-1, keepdims=True)
    p = jnp.exp(s - m)
    l = jnp.sum(p, axis=-1, keepdims=True)
    o = jnp.einsum('bhsk,bskhe->bshe', p / l, vg.astype(jnp.float32))
    lse = jnp.swapaxes((m + jnp.log(l))[..., 0], 1, 2)
    return o, lse


def att_layer(h, kv_bufs, w_in, w_out, t5_bias):
    B, T, _ = h.shape
    proj = h @ w_in
    shp = (B, T, N_GROUPS, HEADS_PER_GROUP, HEAD_DIM)
    q = proj[..., :QKV_WIDTH].reshape(shp)
    k = proj[..., QKV_WIDTH:2 * QKV_WIDTH].reshape(shp)
    v = proj[..., 2 * QKV_WIDTH:3 * QKV_WIDTH].reshape(shp)
    z = proj[..., 3 * QKV_WIDTH:]
    outs, lses, new_kv = [], [], []
    for g, (win, dil) in enumerate(DILATION_PAIRS):
        tab = t5_bias[:, g * HEADS_PER_GROUP:(g + 1) * HEADS_PER_GROUP]
        qg, kg, vg = q[:, :, g], k[:, :, g], v[:, :, g]
        if kv_bufs is None:
            o, lse = dilated_prompt(qg, kg, vg, dil, tab)
            keep = min(win, T)
            new_kv.append(jnp.stack([kg[:, -keep:], vg[:, -keep:]], axis=2))
        else:
            buf = kv_bufs[g]
            k_ext = jnp.concatenate([buf[:, :, 0].astype(kg.dtype), kg], axis=1)
            v_ext = jnp.concatenate([buf[:, :, 1].astype(vg.dtype), vg], axis=1)
            o, lse = dilated_sample(qg, k_ext, v_ext, buf.shape[1], dil, tab)
            new_kv.append(jnp.stack([kg, vg], axis=2))
        outs.append(o)
        lses.append(lse)
    wgt = jax.nn.softmax(jnp.stack(lses, axis=0), axis=0)
    o = jnp.sum(wgt[..., None] * jnp.stack(outs, axis=0), axis=0)
    o = o.reshape(B, T, ATT_WIDTH).astype(h.dtype)
    y = (o * jax.nn.silu(z)) @ w_out
    return y, new_kv


def setup_inputs(seed: int = 0) -> dict:
    key = jax.random.key(seed)
    ks = jax.random.split(key, 20)
    D = D_MODEL

    def nrm(k, shape, s):
        return jax.random.normal(k, shape, jnp.float32) * s

    kv_shape = lambda w: (N_ATT_LAYERS, DEC_BATCH, min(w, PAST_LEN), 2, HEADS_PER_GROUP, HEAD_DIM)
    return {
        "x_prompt": nrm(ks[0], (BATCH, SEQ, D), 1.0),
        "x_sample": nrm(ks[1], (DEC_BATCH, DEC_SEQ, D), 1.0),
        "c_prompt": nrm(ks[2], (BATCH, D), 1.0),
        "c_sample": nrm(ks[3], (DEC_BATCH, D), 1.0),
        "cache_kv0": nrm(ks[4], kv_shape(DILATION_PAIRS[0][0]), 1.0),
        "cache_kv1": nrm(ks[5], kv_shape(DILATION_PAIRS[1][0]), 1.0),
        "cache_kv2": nrm(ks[6], kv_shape(DILATION_PAIRS[2][0]), 1.0),
        "state_pool": nrm(ks[7], (N_POOL_LAYERS, DEC_BATCH, POOL_BUF, POOL_WIDTH), 1.0),
        "norm_pre": 1.0 + nrm(ks[8], (DEPTH, D), 0.05),
        "norm_post": 1.0 + nrm(ks[9], (DEPTH, D), 0.05),
        "ada_w": nrm(ks[10], (DEPTH, D, 3 * D), 0.5 * D ** -0.5),
        "ada_b": nrm(ks[11], (DEPTH, 3 * D), 0.01),
        "t5_bias": nrm(ks[12], (N_BUCKETS, N_SUBHEADS), 0.5),
        "pool_w_in": nrm(ks[13], (N_POOL_LAYERS, D, 2 * POOL_WIDTH), D ** -0.5),
        "pool_w_grp": nrm(ks[14], (N_POOL_LAYERS, len(POOL_WINDOWS), POOL_GROUP, POOL_GROUP), POOL_GROUP ** -0.5),
        "pool_scale": 1.0 + nrm(ks[15], (N_POOL_LAYERS, POOL_WIDTH), 0.1),
        "pool_w_out": nrm(ks[16], (N_POOL_LAYERS, POOL_WIDTH, D), POOL_WIDTH ** -0.5),
        "att_w_in": nrm(ks[17], (N_ATT_LAYERS, D, ATT_IN_COLS), D ** -0.5),
        "att_w_out": nrm(ks[18], (N_ATT_LAYERS, ATT_WIDTH, D), ATT_WIDTH ** -0.5),
    }


def reference(x_prompt, x_sample, c_prompt, c_sample, cache_kv0, cache_kv1, cache_kv2, state_pool,
              norm_pre, norm_post, ada_w, ada_b, t5_bias, pool_w_in, pool_w_grp, pool_scale,
              pool_w_out, att_w_in, att_w_out):
    caches = (cache_kv0, cache_kv1, cache_kv2)
    xp, xs = x_prompt, x_sample
    kv_p = [[] for _ in range(N_GROUPS)]
    kv_s = [[] for _ in range(N_GROUPS)]
    pool_p, pool_s = [], []
    for i in range(DEPTH):
        li = i // 2
        sh_p, sc_p, gt_p = adaln(c_prompt, ada_w[i], ada_b[i])
        sh_s, sc_s, gt_s = adaln(c_sample, ada_w[i], ada_b[i])
        hp = rmsnorm(xp, norm_pre[i]) * (1.0 + sc_p) + sh_p
        hs = rmsnorm(xs, norm_pre[i]) * (1.0 + sc_s) + sh_s
        if i % 2 == 0:
            yp, st_p = pool_layer(hp, None, pool_w_in[li], pool_w_grp[li], pool_scale[li], pool_w_out[li])
            ys, st_s = pool_layer(hs, state_pool[li], pool_w_in[li], pool_w_grp[li], pool_scale[li], pool_w_out[li])
            pool_p.append(st_p)
            pool_s.append(st_s)
        else:
            yp, st_p = att_layer(hp, None, att_w_in[li], att_w_out[li], t5_bias)
            ys, st_s = att_layer(hs, [c[li] for c in caches], att_w_in[li], att_w_out[li], t5_bias)
            for g in range(N_GROUPS):
                kv_p[g].append(st_p[g])
                kv_s[g].append(st_s[g])
        xp = xp + gt_p * rmsnorm(yp, norm_post[i])
        xs = xs + gt_s * rmsnorm(ys, norm_post[i])
    return (xp, xs,
            jnp.stack(kv_p[0]), jnp.stack(kv_p[1]), jnp.stack(kv_p[2]), jnp.stack(pool_p),
            jnp.stack(kv_s[0]), jnp.stack(kv_s[1]), jnp.stack(kv_s[2]), jnp.stack(pool_s))
```

```cpp
#include <hip/hip_runtime.h>
#include <cstdio>
#include <cstdint>
#define GAS __attribute__((address_space(1)))
#define LAS __attribute__((address_space(3)))
namespace pg8 {
#define PG8_LAS __attribute__((address_space(3)))
typedef unsigned short bf16_t;
typedef short bf16x8 __attribute__((ext_vector_type(8)));
typedef float f32x4 __attribute__((ext_vector_type(4)));
typedef unsigned u32x4 __attribute__((ext_vector_type(4)));
constexpr int BM = 256, BK = 64, HALF = 128, HTB = HALF * BK * 2  , STAGE_BYTES = 8 * HTB, NXCD = 8, WGM = 8;

__host__ __device__ __forceinline__ int lds_byte(int r, int c) { const int st = (r >> 4) * 2 + (c >> 5), rr = r & 15, cc = c & 31, ob = rr * 64 + cc * 2; return st * 1024 + (ob ^ (((ob >> 9) & 1) << 5)); }
__host__ __device__ __forceinline__ void stage_rc(int b, int& R, int& C) { const int st = b / 1024, sb = b % 1024, swz = sb ^ (((sb >> 9) & 1) << 5); R = (st >> 1) * 16 + swz / 64; C = (st & 1) * 32 + (swz % 64) / 2; }
__host__ __device__ __forceinline__ int perm32(int rho) { const int n = rho >> 4, i = rho & 15; return 8 * (i >> 2) + 4 * n + (i & 3); }

struct Unit { int pm, pn; };
struct Gemm { const bf16_t* A; const bf16_t* Bt; int M, N, K, lda, agrp; };

struct StaticOrder {
    int nM, nN, nwg, G, c;
    __host__ __device__ void init(int M, int N, int G_, int c_) { nM = M / BM; nN = N / BM; nwg = nM * nN; G = G_; c = c_; }
    __host__ __device__ bool next(int i, Unit& u) const {
        const long L = (long)i * G + c; if (L >= nwg) return false;
        int wgid = (int)L; { const int q = nwg / NXCD, r = nwg % NXCD, xcd = wgid % NXCD, off = wgid / NXCD; wgid = (xcd < r ? xcd * (q + 1) : r * (q + 1) + (xcd - r) * q) + off; }
        const int nig = WGM * nN, gid = wgid / nig, fm = gid * WGM, gsz = (nM - fm) < WGM ? (nM - fm) : WGM;
        u.pm = fm + ((wgid % nig) % gsz); u.pn = (wgid % nig) / gsz; return true;
    }
    __device__ __forceinline__ void a_ready(const Unit&) const {}
    __device__ __forceinline__ void done(const Unit&) const {}
};

template <class Epi, class Sched, bool ALIGN_EPI = false, bool SP2 = false>
__device__ __forceinline__ void gemm_phase(PG8_LAS unsigned char* lds, const Gemm g, const Sched& S, const Epi& E) {
    const int tid = threadIdx.x, wid = __builtin_amdgcn_readfirstlane(tid >> 6), lane = tid & 63, wr = wid >> 2, wc = wid & 3, fr = lane & 15, fq = lane >> 4;
    const int K = g.K, nt = K / BK;
    unsigned voffA[2], voffB[2];
#pragma unroll
    for (int i = 0; i < 2; ++i) { int R, C; stage_rc(tid * 16 + i * 8192, R, C); const int Rb = Epi::PERM ? ((R & ~31) + perm32(R & 31)) : R;
        voffA[i] = (unsigned)(R * g.lda + C) * 2u; voffB[i] = (unsigned)(Rb * K + C) * 2u; }
    const size_t kstep = (size_t)(BK * 2);
    const size_t hstepB = (size_t)HALF * K * 2, hstepA = (size_t)HALF * g.lda * 2;
    const size_t tstepB = 2 * hstepB, tstepA = 2 * hstepA;
    const unsigned ldsw = (unsigned)wid * 1024u;
    const int aoff = lds_byte(wr * 64 + fr, fq * 8), boff = lds_byte(wc * 32 + fr, fq * 8);
#define PG8_SA(b, h) (((b) * 2 + (h)) * HTB)
#define PG8_SB(b, h) ((4 + (b) * 2 + (h)) * HTB)
#define PG8_STAGE(bufoff, gbase, voff) do { _Pragma("unroll") for (int _i = 0; _i < 2; ++_i) \
        __builtin_amdgcn_global_load_lds((const unsigned*)((const char*)(gbase) + (voff)[_i]), (PG8_LAS unsigned*)(lds + (bufoff) + ldsw + _i * 8192), 16, 0, 0); } while (0)
#define PG8_LDA(dst, b, h) do { _Pragma("unroll") for (int m = 0; m < 4; ++m) _Pragma("unroll") for (int k = 0; k < 2; ++k) dst[m][k] = *(const PG8_LAS bf16x8*)(lds + PG8_SA(b, h) + aoff + m * 2048 + k * 1024); } while (0)
#define PG8_LDB(dst, b, h) do { _Pragma("unroll") for (int n = 0; n < 2; ++n) _Pragma("unroll") for (int k = 0; k < 2; ++k) dst[n][k] = *(const PG8_LAS bf16x8*)(lds + PG8_SB(b, h) + boff + n * 2048 + k * 1024); } while (0)
#define PG8_MMA(ai, bj, At, Bt) do { __builtin_amdgcn_s_setprio(1); _Pragma("unroll") for (int m = 0; m < 4; ++m) _Pragma("unroll") for (int n = 0; n < 2; ++n) _Pragma("unroll") for (int k = 0; k < 2; ++k) \
        acc[ai][bj][m][n] = __builtin_amdgcn_mfma_f32_16x16x32_bf16(Bt[n][k], At[m][k], acc[ai][bj][m][n], 0, 0, 0); __builtin_amdgcn_s_setprio(0); } while (0)
#define PG8_WAIT_V(n) asm volatile("s_waitcnt vmcnt(" #n ")" ::: "memory")
#define PG8_WAIT_L(n) asm volatile("s_waitcnt lgkmcnt(" #n ")" ::: "memory")
#define PG8_BAR __builtin_amdgcn_s_barrier()
#define PG8_SCHED __builtin_amdgcn_sched_barrier(0)
    Unit cur, nxt; int ui = 0;
    if (!S.next(0, cur)) return;
    f32x4 acc[2][2][4][2];
#pragma unroll
    for (int a = 0; a < 2; ++a)
#pragma unroll
        for (int b = 0; b < 2; ++b)
#pragma unroll
            for (int m = 0; m < 4; ++m)
#pragma unroll
                for (int n = 0; n < 2; ++n) acc[a][b][m][n] = (f32x4){0.f, 0.f, 0.f, 0.f};
    bf16x8 At[4][2], B0[2][2], B1[2][2];
    const char* cA = (const char*)g.A + (size_t)cur.pm * tstepA + (g.agrp ? (size_t)(cur.pn / g.agrp) * K * 2 : (size_t)0); const char* cB = (const char*)g.Bt + (size_t)cur.pn * tstepB;
    S.a_ready(cur);
    if constexpr (SP2) {
        PG8_STAGE(PG8_SB(0, 0), cB, voffB); PG8_STAGE(PG8_SB(0, 1), cB + hstepB, voffB); PG8_STAGE(PG8_SA(0, 0), cA, voffA); PG8_STAGE(PG8_SA(0, 1), cA + hstepA, voffA);
        if (wr == 1) PG8_BAR;
        PG8_WAIT_V(2); PG8_BAR;
        PG8_STAGE(PG8_SB(1, 0), cB + kstep, voffB); PG8_STAGE(PG8_SA(1, 0), cA + kstep, voffA); PG8_STAGE(PG8_SB(1, 1), cB + hstepB + kstep, voffB);
        PG8_WAIT_V(6); PG8_BAR;
    } else {
        PG8_STAGE(PG8_SB(0, 0), cB, voffB); PG8_STAGE(PG8_SA(0, 0), cA, voffA); PG8_STAGE(PG8_SB(0, 1), cB + hstepB, voffB); PG8_STAGE(PG8_SA(0, 1), cA + hstepA, voffA);
        if (wr == 1) PG8_BAR;
        PG8_WAIT_V(4); PG8_BAR;
        PG8_STAGE(PG8_SB(1, 0), cB + kstep, voffB); PG8_STAGE(PG8_SA(1, 0), cA + kstep, voffA); PG8_STAGE(PG8_SB(1, 1), cB + hstepB + kstep, voffB);
        PG8_WAIT_V(6); PG8_BAR;
    }
    for (;;) {
        const bool has_next = S.next(ui + 1, nxt);
        const char* nA = has_next ? (const char*)g.A + (size_t)nxt.pm * tstepA + (g.agrp ? (size_t)(nxt.pn / g.agrp) * K * 2 : (size_t)0) : cA; const char* nB = has_next ? (const char*)g.Bt + (size_t)nxt.pn * tstepB : cB;
        for (int t = 0; t < nt; t += 2) {
            const bool last = (t == nt - 2);
            const char* a1 = cA + (size_t)(t + 1) * kstep;
            const char* a2 = last ? nA : cA + (size_t)(t + 2) * kstep; const char* b2 = last ? nB : cB + (size_t)(t + 2) * kstep;
            const char* a3 = a2 + kstep; const char* b3 = b2 + kstep;
            if (last && has_next) S.a_ready(nxt);
            if constexpr (SP2) {
            PG8_LDB(B0, 0, 0); PG8_LDB(B1, 0, 1); PG8_SCHED; PG8_LDA(At, 0, 0); PG8_STAGE(PG8_SA(1, 1), a1 + hstepA, voffA);
            PG8_WAIT_V(8); PG8_WAIT_L(0); PG8_BAR; PG8_MMA(0, 0, At, B0); PG8_MMA(0, 1, At, B1); PG8_BAR; PG8_SCHED;
            PG8_LDA(At, 0, 1); PG8_STAGE(PG8_SB(0, 0), b2, voffB); PG8_STAGE(PG8_SB(0, 1), b2 + hstepB, voffB); PG8_STAGE(PG8_SA(0, 0), a2, voffA);
            PG8_WAIT_V(8); PG8_WAIT_L(0); PG8_BAR; PG8_MMA(1, 0, At, B0); PG8_MMA(1, 1, At, B1); PG8_BAR; PG8_SCHED;
            PG8_LDB(B0, 1, 0); PG8_LDB(B1, 1, 1); PG8_SCHED; PG8_LDA(At, 1, 0); PG8_STAGE(PG8_SA(0, 1), a2 + hstepA, voffA);
            PG8_WAIT_V(8); PG8_WAIT_L(0); PG8_BAR; PG8_MMA(0, 0, At, B0); PG8_MMA(0, 1, At, B1); PG8_BAR; PG8_SCHED;
            PG8_LDA(At, 1, 1); PG8_STAGE(PG8_SB(1, 0), b3, voffB); PG8_STAGE(PG8_SB(1, 1), b3 + hstepB, voffB); PG8_STAGE(PG8_SA(1, 0), a3, voffA);
            PG8_WAIT_V(8); PG8_WAIT_L(0); PG8_BAR; PG8_MMA(1, 0, At, B0); PG8_MMA(1, 1, At, B1); PG8_BAR; PG8_SCHED;
            } else {
            PG8_LDB(B0, 0, 0); PG8_SCHED; PG8_LDA(At, 0, 0); PG8_STAGE(PG8_SA(1, 1), a1 + hstepA, voffA);
            PG8_WAIT_L(8); PG8_BAR; PG8_WAIT_L(0); PG8_MMA(0, 0, At, B0); PG8_BAR; PG8_SCHED;
            PG8_LDB(B1, 0, 1); PG8_STAGE(PG8_SB(0, 0), b2, voffB);
            PG8_BAR; PG8_WAIT_L(0); PG8_MMA(0, 1, At, B1); PG8_BAR;
            PG8_LDA(At, 0, 1); PG8_STAGE(PG8_SA(0, 0), a2, voffA);
            PG8_BAR; PG8_WAIT_L(0); PG8_MMA(1, 0, At, B0); PG8_BAR; PG8_SCHED;
            PG8_STAGE(PG8_SB(0, 1), b2 + hstepB, voffB);
            PG8_WAIT_V(6); PG8_BAR; PG8_MMA(1, 1, At, B1); PG8_BAR;
            PG8_LDB(B0, 1, 0); PG8_SCHED; PG8_LDA(At, 1, 0); PG8_STAGE(PG8_SA(0, 1), a2 + hstepA, voffA);
            PG8_WAIT_L(8); PG8_BAR; PG8_WAIT_L(0); PG8_MMA(0, 0, At, B0); PG8_BAR; PG8_SCHED;
            PG8_LDB(B1, 1, 1); PG8_STAGE(PG8_SB(1, 0), b3, voffB);
            PG8_BAR; PG8_WAIT_L(0); PG8_MMA(0, 1, At, B1); PG8_BAR;
            PG8_LDA(At, 1, 1); PG8_STAGE(PG8_SA(1, 0), a3, voffA);
            PG8_BAR; PG8_WAIT_L(0); PG8_MMA(1, 0, At, B0); PG8_BAR; PG8_SCHED;
            PG8_STAGE(PG8_SB(1, 1), b3 + hstepB, voffB);
            PG8_WAIT_V(6); PG8_BAR; PG8_MMA(1, 1, At, B1); PG8_BAR;
            }
        }
        if constexpr (ALIGN_EPI) { if (wr == 0) PG8_BAR; }
        if constexpr (!Epi::AFTER_DRAIN) { E(acc, cur, wr, wc, fr, fq); S.done(cur); }
        if (!has_next) break;
#pragma unroll
        for (int a = 0; a < 2; ++a)
#pragma unroll
            for (int b = 0; b < 2; ++b)
#pragma unroll
                for (int m = 0; m < 4; ++m)
#pragma unroll
                    for (int n = 0; n < 2; ++n) acc[a][b][m][n] = (f32x4){0.f, 0.f, 0.f, 0.f};
        cur = nxt; cA = nA; cB = nB; ++ui;
        if constexpr (ALIGN_EPI) { if (wr == 1) PG8_BAR; }
    }
    PG8_WAIT_V(0);
    if constexpr (!ALIGN_EPI) { if (wr == 0) PG8_BAR; }
    PG8_BAR;
    if constexpr (Epi::AFTER_DRAIN) { E.fused(acc, cur, wr, wc, fr, fq, lds, wid, lane); S.done(cur); }
#undef PG8_SA
#undef PG8_SB
#undef PG8_STAGE
#undef PG8_LDA
#undef PG8_LDB
#undef PG8_MMA
#undef PG8_WAIT_V
#undef PG8_WAIT_L
#undef PG8_BAR
#undef PG8_SCHED
}
}

#define XB_TMO      128
#define XB_XCNT(j)  (256  + 64 * (j))
#define XB_XSUB(j)  (1280 + 64 * (j))
#define XB_XGEN(j)  (2304 + 64 * (j))
#define XB_TOP      3328
#define XB_TOPGEN   3392
#define XCD_BAR_WORDS 3456
#define XB_SPIN_CAP (1u << 18)

__device__ __forceinline__ unsigned xb_ld(unsigned* p)              { return __hip_atomic_load(p, __ATOMIC_RELAXED, __HIP_MEMORY_SCOPE_AGENT); }
__device__ __forceinline__ unsigned xb_add(unsigned* p, unsigned v) { return __hip_atomic_fetch_add(p, v, __ATOMIC_RELAXED, __HIP_MEMORY_SCOPE_AGENT); }
__device__ __forceinline__ unsigned xb_xcc_id() { return (unsigned)__builtin_amdgcn_s_getreg((3 << 11) | 20) & 0xFu; }
#define XB_SPIN(cond, bar) do { unsigned _sp = 0; while (cond) { __builtin_amdgcn_s_sleep(1); \
    if ((++_sp & 255u) == 0u) { if (xb_ld(&(bar)[XB_TMO])) break; if (_sp > XB_SPIN_CAP) { atomicAdd(&(bar)[XB_TMO], 1u); break; } } } } while (0)

struct XcdBarrier {
    unsigned* bar; unsigned x;
    volatile LAS unsigned* st;
};

__device__ __forceinline__ XcdBarrier xcd_barrier_post(unsigned* bar, volatile LAS unsigned* st) {
    XcdBarrier b; b.bar = bar; b.x = xb_xcc_id(); b.st = st;
    if (threadIdx.x == 0) (void)xb_add(&bar[XB_XCNT(b.x)], 1u);
    return b;
}
__device__ __forceinline__ void xcd_barrier_complete(unsigned* bar, unsigned x, unsigned& nloc, unsigned& nx) {
    const unsigned G = gridDim.x * gridDim.y * gridDim.z;
    unsigned sum, cnt, mine, sp = 0u;
    for (;;) {
        sum = 0u; cnt = 0u; mine = 0u;
#pragma unroll
        for (unsigned j = 0; j < 16; ++j) { const unsigned c = xb_ld(&bar[XB_XCNT(j)]); sum += c; cnt += (c > 0u) ? 1u : 0u; mine = (j == x) ? c : mine; }
        if (sum == G) break;
        __builtin_amdgcn_s_sleep(1);
        if ((++sp & 255u) == 0u) { if (xb_ld(&bar[XB_TMO])) break; if (sp > XB_SPIN_CAP) { atomicAdd(&bar[XB_TMO], 1u); break; } }
    }
    nloc = mine > 0u ? mine : 1u; nx = cnt > 0u ? cnt : 1u;
}

__device__ __forceinline__ void xcd_barrier(const XcdBarrier& b) {
    asm volatile("s_waitcnt vmcnt(0)" ::: "memory");
    __syncthreads();
    if (threadIdx.x == 0) {
        unsigned* bar = b.bar;
        __builtin_amdgcn_s_waitcnt(0);
        unsigned nloc = b.st[0], nx = b.st[1];
        if (nloc == 0u) { xcd_barrier_complete(bar, b.x, nloc, nx); b.st[0] = nloc; b.st[1] = nx; }
        const unsigned old = xb_add(&bar[XB_XSUB(b.x)], 1u);
        const unsigned gen = old / nloc;
        if (old + 1u == (gen + 1u) * nloc) {
            __builtin_amdgcn_fence(__ATOMIC_RELEASE, "agent");
            asm volatile("s_waitcnt vmcnt(0)" ::: "memory");
            const unsigned og = xb_add(&bar[XB_TOP], 1u);
            const unsigned tg = og / nx;
            if (og + 1u == (tg + 1u) * nx) xb_add(&bar[XB_TOPGEN], 1u);
            else XB_SPIN(xb_ld(&bar[XB_TOPGEN]) == tg, bar);
            __builtin_amdgcn_fence(__ATOMIC_ACQUIRE, "agent");
            xb_add(&bar[XB_XGEN(b.x)], 1u);
            asm volatile("s_waitcnt vmcnt(0)" ::: "memory");
        } else {
            XB_SPIN(xb_ld(&bar[XB_XGEN(b.x)]) == gen, bar);
            __builtin_amdgcn_fence(__ATOMIC_ACQUIRE, "agent");
            asm volatile("s_waitcnt vmcnt(0)" ::: "memory");
        }
    }
    __syncthreads();
}

#ifndef MK_NAIVE_GEMM
#define MK_NAIVE_GEMM 1
#endif
#ifndef MK_ONE_LAUNCH
#define MK_ONE_LAUNCH 0
#endif

constexpr int D = 2048, NB = 4, SEQ = 2048, MROWS = NB * SEQ, NS = 8;
constexpr int PW = 4096, PIN = 8192, QKVW = 6144, AIN = 20480;
constexpr int NWAVES = 8, NTH = 512;
constexpr float RMS_EPS = 1e-6f, ATT_SCALE = 0.08838834764831845f, NEG_INF = -1e30f;
constexpr size_t O_YP = 0, O_YS = O_YP + (size_t)MROWS * D, O_KV0P = O_YS + (size_t)NS * D, O_KV1P = O_KV0P + (size_t)2 * 4 * 128 * 4096, O_KV2P = O_KV1P + (size_t)2 * 4 * 512 * 4096,
                 O_POOLP = O_KV2P + (size_t)2 * 4 * 2048 * 4096, O_KV0S = O_POOLP + (size_t)2 * 4 * 15 * 4096, O_KV1S = O_KV0S + 2 * 8 * 4096, O_KV2S = O_KV1S + 2 * 8 * 4096,
                 O_POOLS = O_KV2S + 2 * 8 * 4096, O_END = O_POOLS + (size_t)2 * 8 * 15 * 4096;
static_assert(O_END == 106545152, "output size");
constexpr size_t MiB = 1u << 20;
constexpr size_t WS_CTL = 0, CTL_ZERO_BYTES = 1 * MiB;
constexpr size_t WS_MOD = 1 * MiB;
constexpr size_t WS_BIAS = 3 * MiB;
constexpr size_t WS_PS = 4 * MiB;
constexpr size_t WS_RS = 5 * MiB;
constexpr size_t WS_A3S = 6 * MiB;
constexpr size_t WS_WPI = 8 * MiB;
constexpr size_t WS_WPG = 72 * MiB;
constexpr size_t WS_WPO = 88 * MiB;
constexpr size_t WS_WAI = 120 * MiB;
constexpr size_t WS_WAO = 280 * MiB;
constexpr size_t WS_H = 296 * MiB;
constexpr size_t WS_PROJ = 330 * MiB;
constexpr size_t WS_R = 650 * MiB;
constexpr size_t WS_A3 = 714 * MiB;
constexpr size_t WS_Y = 778 * MiB;
constexpr size_t WS_OG = 844 * MiB;
constexpr size_t WS_LSE = 940 * MiB;
constexpr size_t WS_END = 942 * MiB;
constexpr int CW_BAR = 4096;
constexpr int RING_BYTES = 131072, LDSCTL_OFF = RING_BYTES, MISC_OFF = LDSCTL_OFF + 320, LDS_BYTES = 147456;
constexpr int N_PHASES = 22;

typedef unsigned short bf16;
typedef short bf16x8 __attribute__((ext_vector_type(8)));
typedef float f32x4 __attribute__((ext_vector_type(4)));
typedef float f32x2 __attribute__((ext_vector_type(2)));
typedef unsigned u32x4 __attribute__((ext_vector_type(4)));
typedef unsigned u32x2 __attribute__((ext_vector_type(2)));

__device__ __forceinline__ unsigned f2bf(float f) { unsigned u = __builtin_bit_cast(unsigned, f); return (u + 0x7fffu + ((u >> 16) & 1u)) >> 16; }
__device__ __forceinline__ unsigned pk2(float lo, float hi) { return f2bf(lo) | (f2bf(hi) << 16); }
__device__ __forceinline__ float bflo(unsigned w) { return __builtin_bit_cast(float, w << 16); }
__device__ __forceinline__ float bfhi(unsigned w) { return __builtin_bit_cast(float, w & 0xffff0000u); }
__device__ __forceinline__ float silu_f(float x) { return x / (1.0f + __expf(-x)); }
__device__ __forceinline__ float wave_sum(float v) {
#pragma unroll
    for (int o = 1; o < 64; o <<= 1) v += __shfl_xor(v, o);
    return v;
}
__device__ __forceinline__ float wave_max(float v) {
#pragma unroll
    for (int o = 1; o < 64; o <<= 1) v = fmaxf(v, __shfl_xor(v, o));
    return v;
}
__device__ __forceinline__ u32x4 pack8(const f32x4 a, const f32x4 b) { u32x4 w; w.x = pk2(a.x, a.y); w.y = pk2(a.z, a.w); w.z = pk2(b.x, b.y); w.w = pk2(b.z, b.w); return w; }
__device__ __forceinline__ float dot8(const u32x4 a, const u32x4 b) {
    return (bflo(a.x) * bflo(b.x) + bfhi(a.x) * bfhi(b.x)) + (bflo(a.y) * bflo(b.y) + bfhi(a.y) * bfhi(b.y)) + (bflo(a.z) * bflo(b.z) + bfhi(a.z) * bfhi(b.z)) + (bflo(a.w) * bflo(b.w) + bfhi(a.w) * bfhi(b.w));
}

struct Params { const float* in[19]; float* out; unsigned char* ws; int ph_lo, ph_hi; };
struct Ctx { LAS unsigned char* lds; int tid, lane, wave, vcu, G, gw, NGW; };

template <class S8> struct Epi8 {
    static constexpr bool PERM = true, AFTER_DRAIN = false;
    S8 s;
    __device__ __forceinline__ void operator()(const pg8::f32x4 (&acc)[2][2][4][2], const pg8::Unit& u, int wr, int wc, int fr, int fq) const {
        const int row0 = u.pm * 256 + wr * 64 + fr, col0 = u.pn * 256 + wc * 32 + 8 * fq;
#pragma unroll
        for (int ai = 0; ai < 2; ++ai)
#pragma unroll
            for (int m = 0; m < 4; ++m)
#pragma unroll
                for (int bj = 0; bj < 2; ++bj) s.store8(row0 + ai * 128 + m * 16, col0 + bj * 128, acc[ai][bj][m][0], acc[ai][bj][m][1]);
    }
};
struct StG1p {
    bf16* proj; float* outpool;
    __device__ __forceinline__ void store8(int row, int col, const f32x4 v0, const f32x4 v1) const {
        *(u32x4*)(proj + (size_t)row * PIN + col) = pack8(v0, v1);
        const int t = row & (SEQ - 1);
        if (col < PW && t >= SEQ - 15) { float* o = outpool + ((size_t)((row >> 11) * 15 + (t - (SEQ - 15)))) * PW + col; *(f32x4*)o = v0; *(f32x4*)(o + 4) = v1; }
    }
};
struct StG2p {
    const bf16* proj; const float* scale; bf16* a3;
    __device__ __forceinline__ void store8(int row, int col, const f32x4 v0, const f32x4 v1) const {
        const u32x4 z = *(const u32x4*)(proj + (size_t)row * PIN + PW + col);
        const f32x4 s0 = *(const f32x4*)(scale + col), s1 = *(const f32x4*)(scale + col + 4);
        f32x4 a, b;
        a.x = v0.x * s0.x * silu_f(bflo(z.x)); a.y = v0.y * s0.y * silu_f(bfhi(z.x)); a.z = v0.z * s0.z * silu_f(bflo(z.y)); a.w = v0.w * s0.w * silu_f(bfhi(z.y));
        b.x = v1.x * s1.x * silu_f(bflo(z.z)); b.y = v1.y * s1.y * silu_f(bfhi(z.z)); b.z = v1.z * s1.z * silu_f(bflo(z.w)); b.w = v1.w * s1.w * silu_f(bfhi(z.w));
        *(u32x4*)(a3 + (size_t)row * PW + col) = pack8(a, b);
    }
};
struct StF32 {
    float* C; int ldc;
    __device__ __forceinline__ void store8(int row, int col, const f32x4 v0, const f32x4 v1) const { float* o = C + (size_t)row * ldc + col; *(f32x4*)o = v0; *(f32x4*)(o + 4) = v1; }
};
struct StG1a {
    bf16* proj; float* out; int li;
    __device__ __forceinline__ void store8(int row, int col, const f32x4 v0, const f32x4 v1) const {
        *(u32x4*)(proj + (size_t)row * AIN + col) = pack8(v0, v1);
        if (col >= QKVW && col < 3 * QKVW) {
            int cc = col - QKVW; const int kv = cc >= QKVW ? 1 : 0; cc -= kv * QKVW; const int g = cc >> 11, he = cc & 2047, keep = 128 << (2 * g), t = row & (SEQ - 1), b = row >> 11;
            if (t >= SEQ - keep) {
                const size_t base = g == 0 ? O_KV0P : (g == 1 ? O_KV1P : O_KV2P);
                float* o = out + base + ((size_t)((li * 4 + b) * keep + (t - (SEQ - keep)))) * 4096 + kv * 2048 + he; *(f32x4*)o = v0; *(f32x4*)(o + 4) = v1;
            }
        }
    }
};

template <class S8> __device__ __forceinline__ void naive_gemm(const pg8::Gemm g, const S8& st, int gtid, int nth) {
    const int n8 = g.N / 8; const long total = (long)g.M * n8;
    for (long task = gtid; task < total; task += nth) {
        const int row = (int)(task % g.M), col = (int)(task / g.M) * 8;
        const bf16* a = g.A + (size_t)row * g.lda + (g.agrp ? (size_t)(col / (256 * g.agrp)) * g.K : (size_t)0);
        const bf16* b = g.Bt + (size_t)col * g.K;
        float acc[8];
#pragma unroll
        for (int c = 0; c < 8; ++c) acc[c] = 0.f;
        for (int k = 0; k < g.K; k += 8) {
            const u32x4 av = *(const u32x4*)(a + k);
#pragma unroll
            for (int c = 0; c < 8; ++c) acc[c] += dot8(av, *(const u32x4*)(b + (size_t)c * g.K + k));
        }
        st.store8(row, col, (f32x4){acc[0], acc[1], acc[2], acc[3]}, (f32x4){acc[4], acc[5], acc[6], acc[7]});
    }
}
template <class S8> __device__ __forceinline__ void run_gemm(const Ctx& c, const pg8::Gemm g, const S8& st) {
#if MK_NAIVE_GEMM
    naive_gemm(g, st, (int)blockIdx.x * NTH + c.tid, c.G * NTH);
#else
    pg8::StaticOrder S; S.init(g.M, g.N, c.G, (int)blockIdx.x);
    Epi8<S8> E{st};
    pg8::gemm_phase<Epi8<S8>, pg8::StaticOrder, true, true>((PG8_LAS unsigned char*)c.lds, g, S, E);
#endif
}

template <class F> __device__ __forceinline__ void sgemm8(const Ctx& c, const bf16* As, int lda, int agrp_cols, const bf16* Wt, int N, int K, const F& epi) {
    const int q = c.lane >> 4, r = c.lane & 15;
    for (int cg = c.gw; cg < N / 16; cg += c.NGW) {
        const int n = cg * 16 + r;
        const bf16* wrow = Wt + (size_t)n * K + q * 8;
        const bf16* arow = As + (size_t)(r & 7) * lda + (agrp_cols ? ((cg * 16) / agrp_cols) * K : 0) + q * 8;
        pg8::f32x4 acc = {0.f, 0.f, 0.f, 0.f};
#pragma unroll 4
        for (int k0 = 0; k0 < K; k0 += 32) {
            bf16x8 a = *(const bf16x8*)(arow + k0); if (r >= 8) a = (bf16x8){0, 0, 0, 0, 0, 0, 0, 0};
            const bf16x8 b = *(const bf16x8*)(wrow + k0);
            acc = __builtin_amdgcn_mfma_f32_16x16x32_bf16(a, b, acc, 0, 0, 0);
        }
        if (q < 2) {
#pragma unroll
            for (int j = 0; j < 4; ++j) epi(q * 4 + j, n, acc[j]);
        }
    }
}

__device__ __forceinline__ void p0_transpose_item(const float* W, int K, int N, bf16* WT, int row_off, LAS float* scr, int item, int lane) {
    const int nblk = N / 32, kb = item / nblk, nb = item % nblk, k0 = 64 * kb, n0 = 32 * nb;
#pragma unroll 8
    for (int i = 0; i < 32; ++i) { const int kk = 2 * i + (lane >> 5); scr[kk * 33 + (lane & 31)] = W[(size_t)(k0 + kk) * N + n0 + (lane & 31)]; }
    asm volatile("s_waitcnt lgkmcnt(0)" ::: "memory");
    const int cch = lane & 7;
#pragma unroll
    for (int j = 0; j < 4; ++j) { const int n = (lane >> 3) + 8 * j; const LAS float* s = scr + (8 * cch) * 33 + n;
        u32x4 o; o.x = pk2(s[0 * 33], s[1 * 33]); o.y = pk2(s[2 * 33], s[3 * 33]); o.z = pk2(s[4 * 33], s[5 * 33]); o.w = pk2(s[6 * 33], s[7 * 33]);
        *(u32x4*)(WT + (size_t)(row_off + n0 + n) * K + k0 + 8 * cch) = o; }
    asm volatile("s_waitcnt lgkmcnt(0)" ::: "memory");
}
__device__ __forceinline__ void adaln_unit(const Params& p, const Ctx& c, int unit) {
    const int i = unit / 48, n0 = (unit % 48) * 128;
    LAS float* S = (LAS float*)c.lds;
    for (int idx = c.tid; idx < 12 * D; idx += NTH) { const int r = idx >> 11, k = idx & (D - 1); const float cv = r < 4 ? p.in[2][r * D + k] : p.in[3][(r - 4) * D + k]; S[idx] = silu_f(cv); }
    __syncthreads();
    float acc[12][2];
#pragma unroll
    for (int r = 0; r < 12; ++r) { acc[r][0] = 0.f; acc[r][1] = 0.f; }
    const int kb = c.wave * 256;
    const float* W = p.in[10] + ((size_t)i * D + kb) * 6144 + n0 + 2 * c.lane;
    for (int k = 0; k < 256; k += 4) {
        f32x2 w[4];
#pragma unroll
        for (int u = 0; u < 4; ++u) w[u] = *(const f32x2*)(W + (size_t)(k + u) * 6144);
#pragma unroll
        for (int r = 0; r < 12; ++r) { const f32x4 s = *(const LAS f32x4*)(S + r * D + kb + k);
            acc[r][0] += (s.x * w[0].x + s.y * w[1].x) + (s.z * w[2].x + s.w * w[3].x); acc[r][1] += (s.x * w[0].y + s.y * w[1].y) + (s.z * w[2].y + s.w * w[3].y); }
    }
    __syncthreads();
    LAS float* P = (LAS float*)c.lds;
#pragma unroll
    for (int r = 0; r < 12; ++r) { P[(c.wave * 12 + r) * 128 + 2 * c.lane] = acc[r][0]; P[(c.wave * 12 + r) * 128 + 2 * c.lane + 1] = acc[r][1]; }
    __syncthreads();
    float* MOD = (float*)(p.ws + WS_MOD);
    for (int o = c.tid; o < 12 * 128; o += NTH) { const int r = o >> 7, n = o & 127; float s = 0.f;
#pragma unroll
        for (int w = 0; w < 8; ++w) s += P[(w * 12 + r) * 128 + n];
        MOD[(size_t)(i * 12 + r) * 6144 + n0 + n] = s + p.in[11][i * 6144 + n0 + n]; }
    __syncthreads();
}
__device__ __forceinline__ void phase_prologue(const Params& p, const Ctx& c) {
    for (int unit = c.vcu; unit < 192; unit += c.G) adaln_unit(p, c, unit);
    if (c.vcu == c.G - 1) {
        float* BIAS = (float*)(p.ws + WS_BIAS);
        for (int idx = c.tid; idx < 48 * 129; idx += NTH) { const int sh = idx / 129, j = idx % 129, g = sh >> 4, dist = j << (2 * g); int bucket;
            if (dist < 16) bucket = dist; else { const int large = 16 + (int)(log((double)dist / 16.0) / log(128.0) * 16.0); bucket = large < 31 ? large : 31; }
            BIAS[sh * 132 + j] = p.in[12][bucket * 48 + sh]; }
    }
    LAS float* scr = (LAS float*)(c.lds + c.wave * 16384);
    constexpr int I_PI = 32 * 256, I_PG = 16 * 32, I_PO = 64 * 64, I_AI = 32 * 640, I_AO = 32 * 64, I_LAYER = I_PI + 4 * I_PG + I_PO + I_AI + I_AO;
    for (int it = c.gw; it < 2 * I_LAYER; it += c.NGW) {
        const int li = it / I_LAYER; int r = it % I_LAYER;
        if (r < I_PI) { p0_transpose_item(p.in[13] + (size_t)li * D * PIN, D, PIN, (bf16*)(p.ws + WS_WPI) + (size_t)li * PIN * D, 0, scr, r, c.lane); continue; } r -= I_PI;
        if (r < 4 * I_PG) { const int g = r / I_PG; p0_transpose_item(p.in[14] + (size_t)(li * 4 + g) * 1024 * 1024, 1024, 1024, (bf16*)(p.ws + WS_WPG) + (size_t)li * PW * 1024, g * 1024, scr, r % I_PG, c.lane); continue; } r -= 4 * I_PG;
        if (r < I_PO) { p0_transpose_item(p.in[16] + (size_t)li * PW * D, PW, D, (bf16*)(p.ws + WS_WPO) + (size_t)li * D * PW, 0, scr, r, c.lane); continue; } r -= I_PO;
        if (r < I_AI) { p0_transpose_item(p.in[17] + (size_t)li * D * AIN, D, AIN, (bf16*)(p.ws + WS_WAI) + (size_t)li * AIN * D, 0, scr, r, c.lane); continue; } r -= I_AI;
        p0_transpose_item(p.in[18] + (size_t)li * D * D, D, D, (bf16*)(p.ws + WS_WAO) + (size_t)li * D * D, 0, scr, r, c.lane);
    }
}

__device__ __forceinline__ void phase_norm(const Params& p, const Ctx& c, int i) {
    const float* MOD = (const float*)(p.ws + WS_MOD); const float* Y = (const float*)(p.ws + WS_Y); bf16* H = (bf16*)(p.ws + WS_H);
    for (int row = c.gw; row < MROWS + NS; row += c.NGW) {
        const bool smp = row >= MROWS; const int b = smp ? row - MROWS : row >> 11, mr = smp ? 4 + b : b;
        float* xo = smp ? p.out + O_YS + (size_t)b * D : p.out + O_YP + (size_t)row * D;
        const float* xi = (i <= 1) ? (smp ? p.in[1] + (size_t)b * D : p.in[0] + (size_t)row * D) : xo;
        f32x4 v[8];
#pragma unroll
        for (int j = 0; j < 8; ++j) v[j] = ((const f32x4*)xi)[c.lane + 64 * j];
        if (i > 0) {
            f32x4 y[8]; float ss = 0.f;
#pragma unroll
            for (int j = 0; j < 8; ++j) { y[j] = ((const f32x4*)(Y + (size_t)row * D))[c.lane + 64 * j]; ss += (y[j].x * y[j].x + y[j].y * y[j].y) + (y[j].z * y[j].z + y[j].w * y[j].w); }
            const float rstd = 1.0f / sqrtf(wave_sum(ss) * (1.0f / D) + RMS_EPS);
            const f32x4* gate = (const f32x4*)(MOD + (size_t)((i - 1) * 12 + mr) * 6144 + 4096); const f32x4* npo = (const f32x4*)(p.in[9] + (size_t)(i - 1) * D);
#pragma unroll
            for (int j = 0; j < 8; ++j) { const f32x4 g4 = gate[c.lane + 64 * j], n4 = npo[c.lane + 64 * j]; v[j] = v[j] + g4 * (y[j] * rstd * n4); ((f32x4*)xo)[c.lane + 64 * j] = v[j]; }
        }
        if (i < 4) {
            float ss = 0.f;
#pragma unroll
            for (int j = 0; j < 8; ++j) ss += (v[j].x * v[j].x + v[j].y * v[j].y) + (v[j].z * v[j].z + v[j].w * v[j].w);
            const float rstd = 1.0f / sqrtf(wave_sum(ss) * (1.0f / D) + RMS_EPS);
            const f32x4* sh = (const f32x4*)(MOD + (size_t)(i * 12 + mr) * 6144); const f32x4* sc = sh + 512; const f32x4* npr = (const f32x4*)(p.in[8] + (size_t)i * D);
            u32x2* ho = (u32x2*)(H + (size_t)row * D);
#pragma unroll
            for (int j = 0; j < 8; ++j) { const f32x4 s4 = sc[c.lane + 64 * j], h4 = sh[c.lane + 64 * j], n4 = npr[c.lane + 64 * j]; const f32x4 h = v[j] * rstd * n4 * (1.0f + s4) + h4;
                u32x2 w; w.x = pk2(h.x, h.y); w.y = pk2(h.z, h.w); ho[c.lane + 64 * j] = w; }
        }
    }
}

__device__ __forceinline__ void phase_window(const Params& p, const Ctx& c, int li) {
    const bf16* proj = (const bf16*)(p.ws + WS_PROJ); bf16* R = (bf16*)(p.ws + WS_R);
    for (int task = c.vcu * NTH + c.tid; task < MROWS * 512; task += c.G * NTH) {
        const int row = task >> 9, col = (task & 511) * 8, w = 2 << (col >> 10), t = row & (SEQ - 1), n = (t + 1) < w ? (t + 1) : w;
        const bf16* up = proj + (size_t)row * PIN + col;
        const u32x4 u0 = *(const u32x4*)up;
        float a[8] = {bflo(u0.x), bfhi(u0.x), bflo(u0.y), bfhi(u0.y), bflo(u0.z), bfhi(u0.z), bflo(u0.w), bfhi(u0.w)};
        float s[8];
#pragma unroll
        for (int e = 0; e < 8; ++e) s[e] = a[e];
        for (int k = 1; k < n; ++k) { const u32x4 x = *(const u32x4*)(up - (size_t)k * PIN);
            s[0] += bflo(x.x); s[1] += bfhi(x.x); s[2] += bflo(x.y); s[3] += bfhi(x.y); s[4] += bflo(x.z); s[5] += bfhi(x.z); s[6] += bflo(x.w); s[7] += bfhi(x.w); }
        const float inv = 1.0f / (float)n;
        u32x4 o; o.x = pk2(s[0] * inv - a[0], s[1] * inv - a[1]); o.y = pk2(s[2] * inv - a[2], s[3] * inv - a[3]); o.z = pk2(s[4] * inv - a[4], s[5] * inv - a[5]); o.w = pk2(s[6] * inv - a[6], s[7] * inv - a[7]);
        *(u32x4*)(R + (size_t)row * PW + col) = o;
    }
    const float* PS = (const float*)(p.ws + WS_PS); bf16* RS = (bf16*)(p.ws + WS_RS);
    for (int task = c.vcu * NTH + c.tid; task < NS * PW; task += c.G * NTH) {
        const int s = task >> 12, col = task & (PW - 1), w = 2 << (col >> 10);
        const float* st = p.in[7] + ((size_t)(li * NS + s) * 15) * PW + col; float* po = p.out + O_POOLS + ((size_t)(li * NS + s) * 15) * PW + col;
        const float un = PS[(size_t)s * PIN + col]; float sum = un;
        for (int j = 16 - w; j < 15; ++j) sum += st[(size_t)j * PW];
        for (int j = 0; j < 14; ++j) po[(size_t)j * PW] = st[(size_t)(j + 1) * PW];
        po[(size_t)14 * PW] = un;
        RS[(size_t)s * PW + col] = (bf16)f2bf(sum / (float)w - un);
    }
}

__device__ __forceinline__ void phase_attention_naive(const Params& p, const Ctx& c, int li) {
    const bf16* proj = (const bf16*)(p.ws + WS_PROJ); const float* BIAS = (const float*)(p.ws + WS_BIAS); bf16* A2 = (bf16*)(p.ws + WS_A3);
    LAS float* qs = (LAS float*)(c.lds + c.wave * 2048); LAS float* ps = qs + 128;
    for (int task = c.gw; task < MROWS * 16; task += c.NGW) {
        const int row = task >> 4, h = task & 15, t = row & (SEQ - 1);
        float og0[3], og1[3], lse[3];
#pragma unroll
        for (int g = 0; g < 3; ++g) {
            const int dil = 1 << (2 * g), nk = (t / dil) < 128 ? (t / dil) : 128;
            { const unsigned qw = *(const unsigned*)(proj + (size_t)row * AIN + g * 2048 + h * 128 + 2 * c.lane); qs[2 * c.lane] = bflo(qw); qs[2 * c.lane + 1] = bfhi(qw); }
            asm volatile("s_waitcnt lgkmcnt(0)" ::: "memory");
            float s[3], pj[3];
#pragma unroll
            for (int jj = 0; jj < 3; ++jj) {
                const int j = c.lane + 64 * jj; const bool valid = (jj < 2 || c.lane == 0) && j <= nk; float sc = NEG_INF;
                if (valid) { const bf16* kp = proj + (size_t)(row - j * dil) * AIN + QKVW + g * 2048 + h * 128; float dot = 0.f;
#pragma unroll
                    for (int ch = 0; ch < 16; ++ch) { const u32x4 kv = *(const u32x4*)(kp + 8 * ch); const f32x4 q0 = *(const LAS f32x4*)(qs + 8 * ch), q1 = *(const LAS f32x4*)(qs + 8 * ch + 4);
                        dot += (bflo(kv.x) * q0.x + bfhi(kv.x) * q0.y) + (bflo(kv.y) * q0.z + bfhi(kv.y) * q0.w) + (bflo(kv.z) * q1.x + bfhi(kv.z) * q1.y) + (bflo(kv.w) * q1.z + bfhi(kv.w) * q1.w); }
                    sc = dot * ATT_SCALE + BIAS[(g * 16 + h) * 132 + j]; }
                s[jj] = sc;
            }
            const float m = wave_max(fmaxf(fmaxf(s[0], s[1]), s[2]));
            float lsum = 0.f;
#pragma unroll
            for (int jj = 0; jj < 3; ++jj) { const int j = c.lane + 64 * jj; const bool valid = (jj < 2 || c.lane == 0) && j <= nk; pj[jj] = valid ? __expf(s[jj] - m) : 0.f; lsum += pj[jj]; if (jj < 2 || c.lane == 0) ps[j] = pj[jj]; }
            const float l = wave_sum(lsum);
            asm volatile("s_waitcnt lgkmcnt(0)" ::: "memory");
            float o0 = 0.f, o1 = 0.f;
            for (int j = 0; j <= nk; ++j) { const float pv = ps[j]; const unsigned vw = *(const unsigned*)(proj + (size_t)(row - j * dil) * AIN + 2 * QKVW + g * 2048 + h * 128 + 2 * c.lane); o0 += pv * bflo(vw); o1 += pv * bfhi(vw); }
            og0[g] = o0 / l; og1[g] = o1 / l; lse[g] = m + __logf(l);
            asm volatile("s_waitcnt lgkmcnt(0)" ::: "memory");
        }
        const float mm = fmaxf(fmaxf(lse[0], lse[1]), lse[2]); const float w0 = __expf(lse[0] - mm), w1 = __expf(lse[1] - mm), w2 = __expf(lse[2] - mm), wi = 1.0f / (w0 + w1 + w2);
        const unsigned zw = *(const unsigned*)(proj + (size_t)row * AIN + 3 * QKVW + h * 128 + 2 * c.lane);
        const float r0 = (w0 * og0[0] + w1 * og0[1] + w2 * og0[2]) * wi * silu_f(bflo(zw)), r1 = (w0 * og1[0] + w1 * og1[1] + w2 * og1[2]) * wi * silu_f(bfhi(zw));
        *(unsigned*)(A2 + (size_t)row * D + h * 128 + 2 * c.lane) = pk2(r0, r1);
    }
}
__device__ __forceinline__ void phase_attention_sample(const Params& p, const Ctx& c, int li) {
    const float* PS = (const float*)(p.ws + WS_PS); const float* BIAS = (const float*)(p.ws + WS_BIAS); bf16* A2S = (bf16*)(p.ws + WS_A3S);
    LAS float* qs = (LAS float*)(c.lds + c.wave * 2048); LAS float* ps = qs + 128;
    for (int task = c.gw; task < NS * 16; task += c.NGW) {
        const int b = task >> 4, h = task & 15;
        float og0[3], og1[3], lse[3];
#pragma unroll
        for (int g = 0; g < 3; ++g) {
            const int dil = 1 << (2 * g), L = 128 << (2 * g);
            const float* cache = p.in[4 + g] + ((size_t)(li * NS + b) * L) * 4096 + h * 128;
            const float* qp = PS + (size_t)b * AIN + g * 2048 + h * 128;
            qs[2 * c.lane] = qp[2 * c.lane]; qs[2 * c.lane + 1] = qp[2 * c.lane + 1];
            asm volatile("s_waitcnt lgkmcnt(0)" ::: "memory");
            float s[3], pj[3];
#pragma unroll
            for (int jj = 0; jj < 3; ++jj) {
                const int j = c.lane + 64 * jj; const bool valid = (jj < 2 || c.lane == 0); float sc = NEG_INF;
                if (valid) { const float* kp = j == 0 ? PS + (size_t)b * AIN + QKVW + g * 2048 + h * 128 : cache + (size_t)(L - j * dil) * 4096; float dot = 0.f;
#pragma unroll 8
                    for (int ch = 0; ch < 32; ++ch) { const f32x4 kv = *(const f32x4*)(kp + 4 * ch); const f32x4 q0 = *(const LAS f32x4*)(qs + 4 * ch); dot += (kv.x * q0.x + kv.y * q0.y) + (kv.z * q0.z + kv.w * q0.w); }
                    sc = dot * ATT_SCALE + BIAS[(g * 16 + h) * 132 + j]; }
                s[jj] = sc;
            }
            const float m = wave_max(fmaxf(fmaxf(s[0], s[1]), s[2]));
            float lsum = 0.f;
#pragma unroll
            for (int jj = 0; jj < 3; ++jj) { const int j = c.lane + 64 * jj; const bool valid = (jj < 2 || c.lane == 0); pj[jj] = valid ? __expf(s[jj] - m) : 0.f; lsum += pj[jj]; if (valid) ps[j] = pj[jj]; }
            const float l = wave_sum(lsum);
            asm volatile("s_waitcnt lgkmcnt(0)" ::: "memory");
            float o0 = 0.f, o1 = 0.f;
            for (int j = 0; j <= 128; ++j) { const float pv = ps[j]; const float* vp = j == 0 ? PS + (size_t)b * AIN + 2 * QKVW + g * 2048 + h * 128 : cache + (size_t)(L - j * dil) * 4096 + 2048;
                const f32x2 vv = *(const f32x2*)(vp + 2 * c.lane); o0 += pv * vv.x; o1 += pv * vv.y; }
            og0[g] = o0 / l; og1[g] = o1 / l; lse[g] = m + __logf(l);
            asm volatile("s_waitcnt lgkmcnt(0)" ::: "memory");
        }
        const float mm = fmaxf(fmaxf(lse[0], lse[1]), lse[2]); const float w0 = __expf(lse[0] - mm), w1 = __expf(lse[1] - mm), w2 = __expf(lse[2] - mm), wi = 1.0f / (w0 + w1 + w2);
        const f32x2 z = *(const f32x2*)(PS + (size_t)b * AIN + 3 * QKVW + h * 128 + 2 * c.lane);
        const float r0 = (w0 * og0[0] + w1 * og0[1] + w2 * og0[2]) * wi * silu_f(z.x), r1 = (w0 * og1[0] + w1 * og1[1] + w2 * og1[2]) * wi * silu_f(z.y);
        *(unsigned*)(A2S + (size_t)b * D + h * 128 + 2 * c.lane) = pk2(r0, r1);
    }
}

__global__ void __launch_bounds__(NTH, 2) mega_fwd(Params p) {
    extern __shared__ __attribute__((aligned(16))) unsigned char lds_raw[];
    Ctx c;
    c.lds = (LAS unsigned char*)lds_raw;
    c.tid = threadIdx.x; c.lane = c.tid & 63; c.wave = __builtin_amdgcn_readfirstlane(c.tid >> 6);
    c.G = gridDim.x; { const int bx = blockIdx.x; c.vcu = (c.G % 8 == 0) ? (bx % 8) * (c.G / 8) + bx / 8 : bx; }
    c.gw = c.vcu * NWAVES + c.wave; c.NGW = c.G * NWAVES;
    volatile LAS unsigned* MISC = (volatile LAS unsigned*)(c.lds + MISC_OFF);
    for (int u = c.tid; u < (LDS_BYTES - LDSCTL_OFF) / 4; u += NTH) ((LAS unsigned*)(c.lds + LDSCTL_OFF))[u] = 0u;
    __syncthreads();
    unsigned* ctl = (unsigned*)(p.ws + WS_CTL);
    XcdBarrier bar; bar.bar = ctl + CW_BAR; bar.x = 0; bar.st = nullptr;
    const int lo = p.ph_lo, hi = p.ph_hi;
    if (hi - lo > 1) bar = xcd_barrier_post(ctl + CW_BAR, MISC + 8);
#define IN(k) (lo <= (k) && (k) < hi)
#define SEAM(k) do { if (IN(k) && IN((k) + 1)) xcd_barrier(bar); } while (0)
    bf16* const H = (bf16*)(p.ws + WS_H); bf16* const PROJ = (bf16*)(p.ws + WS_PROJ); bf16* const R = (bf16*)(p.ws + WS_R); bf16* const A3 = (bf16*)(p.ws + WS_A3);
    float* const Y = (float*)(p.ws + WS_Y); float* const PS = (float*)(p.ws + WS_PS); bf16* const RS = (bf16*)(p.ws + WS_RS); bf16* const A3S = (bf16*)(p.ws + WS_A3S);

    if (IN(0)) phase_prologue(p, c);
    SEAM(0);
    for (int i = 0; i < 4; ++i) {
        const int ph = 1 + 5 * i, li = i >> 1;
        if (IN(ph)) phase_norm(p, c, i);
        SEAM(ph);
        if (!(i & 1)) {
            const bf16* Wpi = (const bf16*)(p.ws + WS_WPI) + (size_t)li * PIN * D; const bf16* Wpg = (const bf16*)(p.ws + WS_WPG) + (size_t)li * PW * 1024; const bf16* Wpo = (const bf16*)(p.ws + WS_WPO) + (size_t)li * D * PW;
            if (IN(ph + 1)) {
                sgemm8(c, H + (size_t)MROWS * D, D, 0, Wpi, PIN, D, [&](int s, int n, float v) { PS[(size_t)s * PIN + n] = v; });
                run_gemm(c, pg8::Gemm{H, Wpi, MROWS, PIN, D, D, 0}, StG1p{PROJ, p.out + O_POOLP + (size_t)li * 4 * 15 * PW});
            }
            SEAM(ph + 1);
            if (IN(ph + 2)) phase_window(p, c, li);
            SEAM(ph + 2);
            if (IN(ph + 3)) {
                const float* scale = p.in[15] + (size_t)li * PW;
                sgemm8(c, RS, PW, 1024, Wpg, PW, 1024, [&](int s, int n, float v) { A3S[(size_t)s * PW + n] = (bf16)f2bf(v * scale[n] * silu_f(PS[(size_t)s * PIN + PW + n])); });
                run_gemm(c, pg8::Gemm{R, Wpg, MROWS, PW, 1024, PW, 4}, StG2p{PROJ, scale, A3});
            }
            SEAM(ph + 3);
            if (IN(ph + 4)) {
                sgemm8(c, A3S, PW, 0, Wpo, D, PW, [&](int s, int n, float v) { Y[(size_t)(MROWS + s) * D + n] = v; });
                run_gemm(c, pg8::Gemm{A3, Wpo, MROWS, D, PW, PW, 0}, StF32{Y, D});
            }
            SEAM(ph + 4);
        } else {
            const bf16* Wai = (const bf16*)(p.ws + WS_WAI) + (size_t)li * AIN * D; const bf16* Wao = (const bf16*)(p.ws + WS_WAO) + (size_t)li * D * D;
            if (IN(ph + 1)) {
                float* const out = p.out;
                sgemm8(c, H + (size_t)MROWS * D, D, 0, Wai, AIN, D, [&](int s, int n, float v) {
                    PS[(size_t)s * AIN + n] = v;
                    if (n >= QKVW && n < 3 * QKVW) { int cc = n - QKVW; const int kv = cc >= QKVW ? 1 : 0; cc -= kv * QKVW; const int g = cc >> 11, he = cc & 2047;
                        const size_t base = g == 0 ? O_KV0S : (g == 1 ? O_KV1S : O_KV2S); out[base + (size_t)(li * NS + s) * 4096 + kv * 2048 + he] = v; } });
                run_gemm(c, pg8::Gemm{H, Wai, MROWS, AIN, D, D, 0}, StG1a{PROJ, p.out, li});
            }
            SEAM(ph + 1);
            if (IN(ph + 2)) { phase_attention_naive(p, c, li); phase_attention_sample(p, c, li); }
            SEAM(ph + 2);
            if (IN(ph + 3)) { }
            if (IN(ph + 4)) {
                sgemm8(c, A3S, D, 0, Wao, D, D, [&](int s, int n, float v) { Y[(size_t)(MROWS + s) * D + n] = v; });
                run_gemm(c, pg8::Gemm{A3, Wao, MROWS, D, D, D, 0}, StF32{Y, D});
            }
            SEAM(ph + 4);
        }
    }
    if (IN(21)) phase_norm(p, c, 4);
#undef IN
#undef SEAM
}

extern "C" void kernel_launch(void* const* d_in, const int* in_sizes, int n_in, void* d_out, int out_size, void* d_ws, size_t ws_size, hipStream_t stream) {
    static int grid = 0;
    if (grid == 0) {
        if (n_in != 19 || (size_t)out_size != O_END || ws_size < WS_END) { fprintf(stderr, "kernel_launch: unexpected shapes: n_in %d out %d ws %zu; nothing launched\n", n_in, out_size, ws_size); grid = -1; return; }
        int dev = 0, cus = 0, per_cu = 0;
        if (hipGetDevice(&dev) != hipSuccess || hipDeviceGetAttribute(&cus, hipDeviceAttributeMultiprocessorCount, dev) != hipSuccess) { fprintf(stderr, "kernel_launch: device query failed\n"); grid = -1; return; }
        if (hipFuncSetAttribute((const void*)mega_fwd, hipFuncAttributeMaxDynamicSharedMemorySize, LDS_BYTES) != hipSuccess) { fprintf(stderr, "kernel_launch: hipFuncSetAttribute failed\n"); grid = -1; return; }
        if (hipOccupancyMaxActiveBlocksPerMultiprocessor(&per_cu, (const void*)mega_fwd, NTH, LDS_BYTES) != hipSuccess || per_cu < 1) fprintf(stderr, "kernel_launch: occupancy query reports %d workgroups per CU\n", per_cu);
        (void)hipGetLastError();
        grid = cus;
    }
    if (grid < 0) return;
    if (hipMemsetAsync((char*)d_ws + WS_CTL, 0, CTL_ZERO_BYTES, stream) != hipSuccess) { fprintf(stderr, "kernel_launch: memset failed\n"); return; }
    Params p{};
    for (int i = 0; i < 19; ++i) p.in[i] = (const float*)d_in[i];
    p.out = (float*)d_out; p.ws = (unsigned char*)d_ws;
#if MK_ONE_LAUNCH
    p.ph_lo = 0; p.ph_hi = N_PHASES;
    hipLaunchKernelGGL(mega_fwd, dim3(grid), dim3(NTH), LDS_BYTES, stream, p);
#else
    for (int ph = 0; ph < N_PHASES; ++ph) {
        if (ph >= 1 && ph < 21 && ((ph - 1) % 5) == 3 && (((ph - 1) / 5) & 1)) continue;
        p.ph_lo = ph; p.ph_hi = ph + 1;
        hipLaunchKernelGGL(mega_fwd, dim3(grid), dim3(NTH), LDS_BYTES, stream, p);
    }
#endif
    const hipError_t le = hipPeekAtLastError();
    if (le != hipSuccess) fprintf(stderr, "kernel_launch: launch failed: %s\n", hipGetErrorName(le));
}
```

```cpp
#include <hip/hip_runtime.h>
#include <cstdio>
#include <cstdint>
#define GAS __attribute__((address_space(1)))
#define LAS __attribute__((address_space(3)))
namespace pg8 {
#define PG8_LAS __attribute__((address_space(3)))
typedef unsigned short bf16_t;
typedef short bf16x8 __attribute__((ext_vector_type(8)));
typedef float f32x4 __attribute__((ext_vector_type(4)));
typedef unsigned u32x4 __attribute__((ext_vector_type(4)));
constexpr int BM = 256, BK = 64, HALF = 128, HTB = HALF * BK * 2  , STAGE_BYTES = 8 * HTB, NXCD = 8, WGM = 8;

__host__ __device__ __forceinline__ int lds_byte(int r, int c) { const int st = (r >> 4) * 2 + (c >> 5), rr = r & 15, cc = c & 31, ob = rr * 64 + cc * 2; return st * 1024 + (ob ^ (((ob >> 9) & 1) << 5)); }
__host__ __device__ __forceinline__ void stage_rc(int b, int& R, int& C) { const int st = b / 1024, sb = b % 1024, swz = sb ^ (((sb >> 9) & 1) << 5); R = (st >> 1) * 16 + swz / 64; C = (st & 1) * 32 + (swz % 64) / 2; }
__host__ __device__ __forceinline__ int perm32(int rho) { const int n = rho >> 4, i = rho & 15; return 8 * (i >> 2) + 4 * n + (i & 3); }

struct Unit { int pm, pn; };
struct Gemm { const bf16_t* A; const bf16_t* Bt; int M, N, K, lda, agrp; };

struct StaticOrder {
    int nM, nN, nwg, G, c;
    __host__ __device__ void init(int M, int N, int G_, int c_) { nM = M / BM; nN = N / BM; nwg = nM * nN; G = G_; c = c_; }
    __host__ __device__ bool next(int i, Unit& u) const {
        const long L = (long)i * G + c; if (L >= nwg) return false;
        int wgid = (int)L; { const int q = nwg / NXCD, r = nwg % NXCD, xcd = wgid % NXCD, off = wgid / NXCD; wgid = (xcd < r ? xcd * (q + 1) : r * (q + 1) + (xcd - r) * q) + off; }
        const int nig = WGM * nN, gid = wgid / nig, fm = gid * WGM, gsz = (nM - fm) < WGM ? (nM - fm) : WGM;
        u.pm = fm + ((wgid % nig) % gsz); u.pn = (wgid % nig) / gsz; return true;
    }
    __device__ __forceinline__ void a_ready(const Unit&) const {}
    __device__ __forceinline__ void done(const Unit&) const {}
};

template <class Epi, class Sched, bool ALIGN_EPI = false, bool SP2 = false>
__device__ __forceinline__ void gemm_phase(PG8_LAS unsigned char* lds, const Gemm g, const Sched& S, const Epi& E) {
    int tid = threadIdx.x; asm volatile("" : "+v"(tid));
    const int wid = __builtin_amdgcn_readfirstlane(tid >> 6), lane = tid & 63, wr = wid >> 2, wc = wid & 3, fr = lane & 15, fq = lane >> 4;
    const int K = g.K, nt = K / BK;
    unsigned voffA[2], voffB[2];
#pragma unroll
    for (int i = 0; i < 2; ++i) { int R, C; stage_rc(tid * 16 + i * 8192, R, C); const int Rb = Epi::PERM ? ((R & ~31) + perm32(R & 31)) : R;
        voffA[i] = (unsigned)(R * g.lda + C) * 2u; voffB[i] = (unsigned)(Rb * K + C) * 2u; }
    const size_t kstep = (size_t)(BK * 2);
    const size_t hstepB = (size_t)HALF * K * 2, hstepA = (size_t)HALF * g.lda * 2;
    const size_t tstepB = 2 * hstepB, tstepA = 2 * hstepA;
    const unsigned ldsw = (unsigned)wid * 1024u;
    const int aoff = lds_byte(wr * 64 + fr, fq * 8), boff = lds_byte(wc * 32 + fr, fq * 8);
#define PG8_SA(b, h) (((b) * 2 + (h)) * HTB)
#define PG8_SB(b, h) ((4 + (b) * 2 + (h)) * HTB)
#define PG8_STAGE(bufoff, gbase, voff) do { _Pragma("unroll") for (int _i = 0; _i < 2; ++_i) \
        __builtin_amdgcn_global_load_lds((const unsigned*)((const char*)(gbase) + (voff)[_i]), (PG8_LAS unsigned*)(lds + (bufoff) + ldsw + _i * 8192), 16, 0, 0); } while (0)
#define PG8_LDA(dst, b, h) do { _Pragma("unroll") for (int m = 0; m < 4; ++m) _Pragma("unroll") for (int k = 0; k < 2; ++k) dst[m][k] = *(const PG8_LAS bf16x8*)(lds + PG8_SA(b, h) + aoff + m * 2048 + k * 1024); } while (0)
#define PG8_LDB(dst, b, h) do { _Pragma("unroll") for (int n = 0; n < 2; ++n) _Pragma("unroll") for (int k = 0; k < 2; ++k) dst[n][k] = *(const PG8_LAS bf16x8*)(lds + PG8_SB(b, h) + boff + n * 2048 + k * 1024); } while (0)
#define PG8_MMA(ai, bj, At, Bt) do { __builtin_amdgcn_s_setprio(1); _Pragma("unroll") for (int m = 0; m < 4; ++m) _Pragma("unroll") for (int n = 0; n < 2; ++n) _Pragma("unroll") for (int k = 0; k < 2; ++k) \
        acc[ai][bj][m][n] = __builtin_amdgcn_mfma_f32_16x16x32_bf16(Bt[n][k], At[m][k], acc[ai][bj][m][n], 0, 0, 0); __builtin_amdgcn_s_setprio(0); } while (0)
#define PG8_WAIT_V(n) asm volatile("s_waitcnt vmcnt(" #n ")" ::: "memory")
#define PG8_WAIT_L(n) asm volatile("s_waitcnt lgkmcnt(" #n ")" ::: "memory")
#define PG8_BAR __builtin_amdgcn_s_barrier()
#define PG8_SCHED __builtin_amdgcn_sched_barrier(0)
    Unit cur, nxt; int ui = 0;
    if (!S.next(0, cur)) return;
    f32x4 acc[2][2][4][2];
#pragma unroll
    for (int a = 0; a < 2; ++a)
#pragma unroll
        for (int b = 0; b < 2; ++b)
#pragma unroll
            for (int m = 0; m < 4; ++m)
#pragma unroll
                for (int n = 0; n < 2; ++n) acc[a][b][m][n] = (f32x4){0.f, 0.f, 0.f, 0.f};
    bf16x8 At[4][2], B0[2][2], B1[2][2];
    const char* cA = (const char*)g.A + (size_t)cur.pm * tstepA + (g.agrp ? (size_t)(cur.pn / g.agrp) * K * 2 : (size_t)0); const char* cB = (const char*)g.Bt + (size_t)cur.pn * tstepB;
    S.a_ready(cur);
    if constexpr (SP2) {
        PG8_STAGE(PG8_SB(0, 0), cB, voffB); PG8_STAGE(PG8_SB(0, 1), cB + hstepB, voffB); PG8_STAGE(PG8_SA(0, 0), cA, voffA); PG8_STAGE(PG8_SA(0, 1), cA + hstepA, voffA);
        if (wr == 1) PG8_BAR;
        PG8_WAIT_V(2); PG8_BAR;
        PG8_STAGE(PG8_SB(1, 0), cB + kstep, voffB); PG8_STAGE(PG8_SA(1, 0), cA + kstep, voffA); PG8_STAGE(PG8_SB(1, 1), cB + hstepB + kstep, voffB);
        PG8_WAIT_V(6); PG8_BAR;
    } else {
        PG8_STAGE(PG8_SB(0, 0), cB, voffB); PG8_STAGE(PG8_SA(0, 0), cA, voffA); PG8_STAGE(PG8_SB(0, 1), cB + hstepB, voffB); PG8_STAGE(PG8_SA(0, 1), cA + hstepA, voffA);
        if (wr == 1) PG8_BAR;
        PG8_WAIT_V(4); PG8_BAR;
        PG8_STAGE(PG8_SB(1, 0), cB + kstep, voffB); PG8_STAGE(PG8_SA(1, 0), cA + kstep, voffA); PG8_STAGE(PG8_SB(1, 1), cB + hstepB + kstep, voffB);
        PG8_WAIT_V(6); PG8_BAR;
    }
    for (;;) {
        const bool has_next = S.next(ui + 1, nxt);
        const char* nA = has_next ? (const char*)g.A + (size_t)nxt.pm * tstepA + (g.agrp ? (size_t)(nxt.pn / g.agrp) * K * 2 : (size_t)0) : cA; const char* nB = has_next ? (const char*)g.Bt + (size_t)nxt.pn * tstepB : cB;
        for (int t = 0; t < nt; t += 2) {
            const bool last = (t == nt - 2);
            const char* a1 = cA + (size_t)(t + 1) * kstep;
            const char* a2 = last ? nA : cA + (size_t)(t + 2) * kstep; const char* b2 = last ? nB : cB + (size_t)(t + 2) * kstep;
            const char* a3 = a2 + kstep; const char* b3 = b2 + kstep;
            if (last && has_next) S.a_ready(nxt);
            if constexpr (SP2) {
            PG8_LDB(B0, 0, 0); PG8_LDB(B1, 0, 1); PG8_SCHED; PG8_LDA(At, 0, 0); PG8_STAGE(PG8_SA(1, 1), a1 + hstepA, voffA);
            PG8_WAIT_V(8); PG8_WAIT_L(0); PG8_BAR; PG8_MMA(0, 0, At, B0); PG8_MMA(0, 1, At, B1); PG8_BAR; PG8_SCHED;
            PG8_LDA(At, 0, 1); PG8_STAGE(PG8_SB(0, 0), b2, voffB); PG8_STAGE(PG8_SB(0, 1), b2 + hstepB, voffB); PG8_STAGE(PG8_SA(0, 0), a2, voffA);
            PG8_WAIT_V(8); PG8_WAIT_L(0); PG8_BAR; PG8_MMA(1, 0, At, B0); PG8_MMA(1, 1, At, B1); PG8_BAR; PG8_SCHED;
            PG8_LDB(B0, 1, 0); PG8_LDB(B1, 1, 1); PG8_SCHED; PG8_LDA(At, 1, 0); PG8_STAGE(PG8_SA(0, 1), a2 + hstepA, voffA);
            PG8_WAIT_V(8); PG8_WAIT_L(0); PG8_BAR; PG8_MMA(0, 0, At, B0); PG8_MMA(0, 1, At, B1); PG8_BAR; PG8_SCHED;
            PG8_LDA(At, 1, 1); PG8_STAGE(PG8_SB(1, 0), b3, voffB); PG8_STAGE(PG8_SB(1, 1), b3 + hstepB, voffB); PG8_STAGE(PG8_SA(1, 0), a3, voffA);
            PG8_WAIT_V(8); PG8_WAIT_L(0); PG8_BAR; PG8_MMA(1, 0, At, B0); PG8_MMA(1, 1, At, B1); PG8_BAR; PG8_SCHED;
            } else {
            PG8_LDB(B0, 0, 0); PG8_SCHED; PG8_LDA(At, 0, 0); PG8_STAGE(PG8_SA(1, 1), a1 + hstepA, voffA);
            PG8_WAIT_L(8); PG8_BAR; PG8_WAIT_L(0); PG8_MMA(0, 0, At, B0); PG8_BAR; PG8_SCHED;
            PG8_LDB(B1, 0, 1); PG8_STAGE(PG8_SB(0, 0), b2, voffB);
            PG8_BAR; PG8_WAIT_L(0); PG8_MMA(0, 1, At, B1); PG8_BAR;
            PG8_LDA(At, 0, 1); PG8_STAGE(PG8_SA(0, 0), a2, voffA);
            PG8_BAR; PG8_WAIT_L(0); PG8_MMA(1, 0, At, B0); PG8_BAR; PG8_SCHED;
            PG8_STAGE(PG8_SB(0, 1), b2 + hstepB, voffB);
            PG8_WAIT_V(6); PG8_BAR; PG8_MMA(1, 1, At, B1); PG8_BAR;
            PG8_LDB(B0, 1, 0); PG8_SCHED; PG8_LDA(At, 1, 0); PG8_STAGE(PG8_SA(0, 1), a2 + hstepA, voffA);
            PG8_WAIT_L(8); PG8_BAR; PG8_WAIT_L(0); PG8_MMA(0, 0, At, B0); PG8_BAR; PG8_SCHED;
            PG8_LDB(B1, 1, 1); PG8_STAGE(PG8_SB(1, 0), b3, voffB);
            PG8_BAR; PG8_WAIT_L(0); PG8_MMA(0, 1, At, B1); PG8_BAR;
            PG8_LDA(At, 1, 1); PG8_STAGE(PG8_SA(1, 0), a3, voffA);
            PG8_BAR; PG8_WAIT_L(0); PG8_MMA(1, 0, At, B0); PG8_BAR; PG8_SCHED;
            PG8_STAGE(PG8_SB(1, 1), b3 + hstepB, voffB);
            PG8_WAIT_V(6); PG8_BAR; PG8_MMA(1, 1, At, B1); PG8_BAR;
            }
        }
        if constexpr (ALIGN_EPI) { if (wr == 0) PG8_BAR; }
        if constexpr (!Epi::AFTER_DRAIN) { E(acc, cur, wr, wc, fr, fq); S.done(cur); }
        if (!has_next) break;
#pragma unroll
        for (int a = 0; a < 2; ++a)
#pragma unroll
            for (int b = 0; b < 2; ++b)
#pragma unroll
                for (int m = 0; m < 4; ++m)
#pragma unroll
                    for (int n = 0; n < 2; ++n) acc[a][b][m][n] = (f32x4){0.f, 0.f, 0.f, 0.f};
        cur = nxt; cA = nA; cB = nB; ++ui;
        if constexpr (ALIGN_EPI) { if (wr == 1) PG8_BAR; }
    }
    PG8_WAIT_V(0);
    if constexpr (!ALIGN_EPI) { if (wr == 0) PG8_BAR; }
    PG8_BAR;
    if constexpr (Epi::AFTER_DRAIN) { E.fused(acc, cur, wr, wc, fr, fq, lds, wid, lane); S.done(cur); }
#undef PG8_SA
#undef PG8_SB
#undef PG8_STAGE
#undef PG8_LDA
#undef PG8_LDB
#undef PG8_MMA
#undef PG8_WAIT_V
#undef PG8_WAIT_L
#undef PG8_BAR
#undef PG8_SCHED
}
}

#define XB_TMO      128
#define XB_XCNT(j)  (256  + 64 * (j))
#define XB_XSUB(j)  (1280 + 64 * (j))
#define XB_XGEN(j)  (2304 + 64 * (j))
#define XB_TOP      3328
#define XB_TOPGEN   3392
#define XCD_BAR_WORDS 3456
#define XB_SPIN_CAP (1u << 18)

__device__ __forceinline__ unsigned xb_ld(unsigned* p)              { return __hip_atomic_load(p, __ATOMIC_RELAXED, __HIP_MEMORY_SCOPE_AGENT); }
__device__ __forceinline__ unsigned xb_add(unsigned* p, unsigned v) { return __hip_atomic_fetch_add(p, v, __ATOMIC_RELAXED, __HIP_MEMORY_SCOPE_AGENT); }
__device__ __forceinline__ unsigned xb_xcc_id() { return (unsigned)__builtin_amdgcn_s_getreg((3 << 11) | 20) & 0xFu; }
#define XB_SPIN(cond, bar) do { unsigned _sp = 0; while (cond) { __builtin_amdgcn_s_sleep(1); \
    if ((++_sp & 255u) == 0u) { if (xb_ld(&(bar)[XB_TMO])) break; if (_sp > XB_SPIN_CAP) { atomicAdd(&(bar)[XB_TMO], 1u); break; } } } } while (0)

struct XcdBarrier {
    unsigned* bar; unsigned x;
    volatile LAS unsigned* st;
};

__device__ __forceinline__ XcdBarrier xcd_barrier_post(unsigned* bar, volatile LAS unsigned* st) {
    XcdBarrier b; b.bar = bar; b.x = xb_xcc_id(); b.st = st;
    if (threadIdx.x == 0) (void)xb_add(&bar[XB_XCNT(b.x)], 1u);
    return b;
}
__device__ __forceinline__ void xcd_barrier_complete(unsigned* bar, unsigned x, unsigned& nloc, unsigned& nx) {
    const unsigned G = gridDim.x * gridDim.y * gridDim.z;
    unsigned sum, cnt, mine, sp = 0u;
    for (;;) {
        sum = 0u; cnt = 0u; mine = 0u;
#pragma unroll
        for (unsigned j = 0; j < 16; ++j) { const unsigned c = xb_ld(&bar[XB_XCNT(j)]); sum += c; cnt += (c > 0u) ? 1u : 0u; mine = (j == x) ? c : mine; }
        if (sum == G) break;
        __builtin_amdgcn_s_sleep(1);
        if ((++sp & 255u) == 0u) { if (xb_ld(&bar[XB_TMO])) break; if (sp > XB_SPIN_CAP) { atomicAdd(&bar[XB_TMO], 1u); break; } }
    }
    nloc = mine > 0u ? mine : 1u; nx = cnt > 0u ? cnt : 1u;
}

__device__ __forceinline__ void xcd_barrier(const XcdBarrier& b) {
    asm volatile("s_waitcnt vmcnt(0)" ::: "memory");
    __syncthreads();
    if (threadIdx.x == 0) {
        unsigned* bar = b.bar;
        __builtin_amdgcn_s_waitcnt(0);
        unsigned nloc = b.st[0], nx = b.st[1];
        if (nloc == 0u) { xcd_barrier_complete(bar, b.x, nloc, nx); b.st[0] = nloc; b.st[1] = nx; }
        const unsigned old = xb_add(&bar[XB_XSUB(b.x)], 1u);
        const unsigned gen = old / nloc;
        if (old + 1u == (gen + 1u) * nloc) {
            __builtin_amdgcn_fence(__ATOMIC_RELEASE, "agent");
            asm volatile("s_waitcnt vmcnt(0)" ::: "memory");
            const unsigned og = xb_add(&bar[XB_TOP], 1u);
            const unsigned tg = og / nx;
            if (og + 1u == (tg + 1u) * nx) xb_add(&bar[XB_TOPGEN], 1u);
            else XB_SPIN(xb_ld(&bar[XB_TOPGEN]) == tg, bar);
            __builtin_amdgcn_fence(__ATOMIC_ACQUIRE, "agent");
            xb_add(&bar[XB_XGEN(b.x)], 1u);
            asm volatile("s_waitcnt vmcnt(0)" ::: "memory");
        } else {
            XB_SPIN(xb_ld(&bar[XB_XGEN(b.x)]) == gen, bar);
            __builtin_amdgcn_fence(__ATOMIC_ACQUIRE, "agent");
            asm volatile("s_waitcnt vmcnt(0)" ::: "memory");
        }
    }
    __syncthreads();
}

#ifndef MK_NAIVE_GEMM
#define MK_NAIVE_GEMM 0
#endif
#ifndef MK_ONE_LAUNCH
#define MK_ONE_LAUNCH 1
#endif

constexpr int D = 2048, NB = 4, SEQ = 2048, MROWS = NB * SEQ, NS = 8;
constexpr int PW = 4096, PIN = 8192, QKVW = 6144, AIN = 20480;
constexpr int NWAVES = 8, NTH = 512;
constexpr float RMS_EPS = 1e-6f, ATT_SCALE = 0.08838834764831845f, NEG_INF = -1e30f;
constexpr size_t O_YP = 0, O_YS = O_YP + (size_t)MROWS * D, O_KV0P = O_YS + (size_t)NS * D, O_KV1P = O_KV0P + (size_t)2 * 4 * 128 * 4096, O_KV2P = O_KV1P + (size_t)2 * 4 * 512 * 4096,
                 O_POOLP = O_KV2P + (size_t)2 * 4 * 2048 * 4096, O_KV0S = O_POOLP + (size_t)2 * 4 * 15 * 4096, O_KV1S = O_KV0S + 2 * 8 * 4096, O_KV2S = O_KV1S + 2 * 8 * 4096,
                 O_POOLS = O_KV2S + 2 * 8 * 4096, O_END = O_POOLS + (size_t)2 * 8 * 15 * 4096;
static_assert(O_END == 106545152, "output size");
constexpr size_t MiB = 1u << 20;
constexpr size_t WS_CTL = 0, CTL_ZERO_BYTES = 1 * MiB;
constexpr size_t WS_MOD = 1 * MiB;
constexpr size_t WS_BIAS = 3 * MiB;
constexpr size_t WS_PS = 4 * MiB;
constexpr size_t WS_RS = 5 * MiB;
constexpr size_t WS_A3S = 6 * MiB;
constexpr size_t WS_WPI = 8 * MiB;
constexpr size_t WS_WPG = 72 * MiB;
constexpr size_t WS_WPO = 88 * MiB;
constexpr size_t WS_WAI = 120 * MiB;
constexpr size_t WS_WAO = 280 * MiB;
constexpr size_t WS_H = 296 * MiB;
constexpr size_t WS_PROJ = 330 * MiB;
constexpr size_t WS_R = 650 * MiB;
constexpr size_t WS_A3 = 714 * MiB;
constexpr size_t WS_Y = 778 * MiB;
constexpr size_t WS_OG = 844 * MiB;
constexpr size_t WS_LSE = 940 * MiB;
constexpr size_t WS_END = 942 * MiB;
constexpr int CW_BAR = 4096;
constexpr int RING_BYTES = 131072, LDSCTL_OFF = RING_BYTES, MISC_OFF = LDSCTL_OFF + 320, LDS_BYTES = 147456;
constexpr int N_PHASES = 22;

typedef unsigned short bf16;
typedef short bf16x8 __attribute__((ext_vector_type(8)));
typedef float f32x4 __attribute__((ext_vector_type(4)));
typedef float f32x2 __attribute__((ext_vector_type(2)));
typedef unsigned u32x4 __attribute__((ext_vector_type(4)));
typedef unsigned u32x2 __attribute__((ext_vector_type(2)));

__device__ __forceinline__ unsigned f2bf(float f) { unsigned u = __builtin_bit_cast(unsigned, f); return (u + 0x7fffu + ((u >> 16) & 1u)) >> 16; }
__device__ __forceinline__ unsigned pk2(float lo, float hi) { return f2bf(lo) | (f2bf(hi) << 16); }
__device__ __forceinline__ float bflo(unsigned w) { return __builtin_bit_cast(float, w << 16); }
__device__ __forceinline__ float bfhi(unsigned w) { return __builtin_bit_cast(float, w & 0xffff0000u); }
__device__ __forceinline__ float silu_f(float x) { return x / (1.0f + __expf(-x)); }
__device__ __forceinline__ float wave_sum(float v) {
#pragma unroll
    for (int o = 1; o < 64; o <<= 1) v += __shfl_xor(v, o);
    return v;
}
__device__ __forceinline__ float wave_max(float v) {
#pragma unroll
    for (int o = 1; o < 64; o <<= 1) v = fmaxf(v, __shfl_xor(v, o));
    return v;
}
__device__ __forceinline__ u32x4 pack8(const f32x4 a, const f32x4 b) { u32x4 w; w.x = pk2(a.x, a.y); w.y = pk2(a.z, a.w); w.z = pk2(b.x, b.y); w.w = pk2(b.z, b.w); return w; }
__device__ __forceinline__ float dot8(const u32x4 a, const u32x4 b) {
    return (bflo(a.x) * bflo(b.x) + bfhi(a.x) * bfhi(b.x)) + (bflo(a.y) * bflo(b.y) + bfhi(a.y) * bfhi(b.y)) + (bflo(a.z) * bflo(b.z) + bfhi(a.z) * bfhi(b.z)) + (bflo(a.w) * bflo(b.w) + bfhi(a.w) * bfhi(b.w));
}

struct Params { const float* in[19]; float* out; unsigned char* ws; int ph_lo, ph_hi; };
struct Ctx { LAS unsigned char* lds; int tid, lane, wave, vcu, G, gw, NGW; };

template <class S8> struct Epi8 {
    static constexpr bool PERM = true, AFTER_DRAIN = false;
    S8 s;
    __device__ __forceinline__ void operator()(const pg8::f32x4 (&acc)[2][2][4][2], const pg8::Unit& u, int wr, int wc, int fr, int fq) const {
        const int row0 = u.pm * 256 + wr * 64 + fr, col0 = u.pn * 256 + wc * 32 + 8 * fq;
#pragma unroll
        for (int ai = 0; ai < 2; ++ai)
#pragma unroll
            for (int m = 0; m < 4; ++m)
#pragma unroll
                for (int bj = 0; bj < 2; ++bj) s.store8(row0 + ai * 128 + m * 16, col0 + bj * 128, acc[ai][bj][m][0], acc[ai][bj][m][1]);
    }
};
struct StG1p {
    bf16* proj; float* outpool;
    __device__ __forceinline__ void store8(int row, int col, const f32x4 v0, const f32x4 v1) const {
        *(u32x4*)(proj + (size_t)row * PIN + col) = pack8(v0, v1);
        const int t = row & (SEQ - 1);
        if (col < PW && t >= SEQ - 15) { float* o = outpool + ((size_t)((row >> 11) * 15 + (t - (SEQ - 15)))) * PW + col; *(f32x4*)o = v0; *(f32x4*)(o + 4) = v1; }
    }
};
struct StG2p {
    const bf16* proj; const float* scale; bf16* a3;
    __device__ __forceinline__ void store8(int row, int col, const f32x4 v0, const f32x4 v1) const {
        const u32x4 z = *(const u32x4*)(proj + (size_t)row * PIN + PW + col);
        const f32x4 s0 = *(const f32x4*)(scale + col), s1 = *(const f32x4*)(scale + col + 4);
        f32x4 a, b;
        a.x = v0.x * s0.x * silu_f(bflo(z.x)); a.y = v0.y * s0.y * silu_f(bfhi(z.x)); a.z = v0.z * s0.z * silu_f(bflo(z.y)); a.w = v0.w * s0.w * silu_f(bfhi(z.y));
        b.x = v1.x * s1.x * silu_f(bflo(z.z)); b.y = v1.y * s1.y * silu_f(bfhi(z.z)); b.z = v1.z * s1.z * silu_f(bflo(z.w)); b.w = v1.w * s1.w * silu_f(bfhi(z.w));
        *(u32x4*)(a3 + (size_t)row * PW + col) = pack8(a, b);
    }
};
struct StF32 {
    float* C; int ldc;
    __device__ __forceinline__ void store8(int row, int col, const f32x4 v0, const f32x4 v1) const { float* o = C + (size_t)row * ldc + col; *(f32x4*)o = v0; *(f32x4*)(o + 4) = v1; }
};
struct StG1a {
    bf16* proj; float* out; int li;
    __device__ __forceinline__ void store8(int row, int col, const f32x4 v0, const f32x4 v1) const {
        *(u32x4*)(proj + (size_t)row * AIN + col) = pack8(v0, v1);
        if (col >= QKVW && col < 3 * QKVW) {
            int cc = col - QKVW; const int kv = cc >= QKVW ? 1 : 0; cc -= kv * QKVW; const int g = cc >> 11, he = cc & 2047, keep = 128 << (2 * g), t = row & (SEQ - 1), b = row >> 11;
            if (t >= SEQ - keep) {
                const size_t base = g == 0 ? O_KV0P : (g == 1 ? O_KV1P : O_KV2P);
                float* o = out + base + ((size_t)((li * 4 + b) * keep + (t - (SEQ - keep)))) * 4096 + kv * 2048 + he; *(f32x4*)o = v0; *(f32x4*)(o + 4) = v1;
            }
        }
    }
};

template <class S8> __device__ __forceinline__ void naive_gemm(const pg8::Gemm g, const S8& st, int gtid, int nth) {
    const int n8 = g.N / 8; const long total = (long)g.M * n8;
    for (long task = gtid; task < total; task += nth) {
        const int row = (int)(task % g.M), col = (int)(task / g.M) * 8;
        const bf16* a = g.A + (size_t)row * g.lda + (g.agrp ? (size_t)(col / (256 * g.agrp)) * g.K : (size_t)0);
        const bf16* b = g.Bt + (size_t)col * g.K;
        float acc[8];
#pragma unroll
        for (int c = 0; c < 8; ++c) acc[c] = 0.f;
        for (int k = 0; k < g.K; k += 8) {
            const u32x4 av = *(const u32x4*)(a + k);
#pragma unroll
            for (int c = 0; c < 8; ++c) acc[c] += dot8(av, *(const u32x4*)(b + (size_t)c * g.K + k));
        }
        st.store8(row, col, (f32x4){acc[0], acc[1], acc[2], acc[3]}, (f32x4){acc[4], acc[5], acc[6], acc[7]});
    }
}
#ifndef MK_FAST_MASK
#define MK_FAST_MASK 31
#endif
template <int SITE, class S8> __device__ __forceinline__ void run_gemm(const Ctx& c, const pg8::Gemm g, const S8& st) {
    if constexpr (MK_NAIVE_GEMM || !((MK_FAST_MASK >> SITE) & 1)) naive_gemm(g, st, (int)blockIdx.x * NTH + c.tid, c.G * NTH);
    else {
        pg8::StaticOrder S; S.init(g.M, g.N, c.G, (int)blockIdx.x);
        Epi8<S8> E{st};
        pg8::gemm_phase<Epi8<S8>, pg8::StaticOrder, true, true>((PG8_LAS unsigned char*)c.lds, g, S, E);
    }
}

template <class F> __device__ __forceinline__ void sgemm8(const Ctx& c, const bf16* As, int lda, int agrp_cols, const bf16* Wt, int N, int K, const F& epi) {
    const int q = c.lane >> 4, r = c.lane & 15;
    for (int cg = c.gw; cg < N / 16; cg += c.NGW) {
        const int n = cg * 16 + r;
        const bf16* wrow = Wt + (size_t)n * K + q * 8;
        const bf16* arow = As + (size_t)(r & 7) * lda + (agrp_cols ? ((cg * 16) / agrp_cols) * K : 0) + q * 8;
        pg8::f32x4 acc = {0.f, 0.f, 0.f, 0.f};
#pragma unroll 4
        for (int k0 = 0; k0 < K; k0 += 32) {
            bf16x8 a = *(const bf16x8*)(arow + k0); if (r >= 8) a = (bf16x8){0, 0, 0, 0, 0, 0, 0, 0};
            const bf16x8 b = *(const bf16x8*)(wrow + k0);
            acc = __builtin_amdgcn_mfma_f32_16x16x32_bf16(a, b, acc, 0, 0, 0);
        }
        if (q < 2) {
#pragma unroll
            for (int j = 0; j < 4; ++j) epi(q * 4 + j, n, acc[j]);
        }
    }
}

__device__ __forceinline__ void p0_transpose_item(const float* W, int K, int N, bf16* WT, int row_off, LAS float* scr, int item, int lane) {
    const int nblk = N / 32, kb = item / nblk, nb = item % nblk, k0 = 64 * kb, n0 = 32 * nb;
#pragma unroll 8
    for (int i = 0; i < 32; ++i) { const int kk = 2 * i + (lane >> 5); scr[kk * 33 + (lane & 31)] = W[(size_t)(k0 + kk) * N + n0 + (lane & 31)]; }
    asm volatile("s_waitcnt lgkmcnt(0)" ::: "memory");
    const int cch = lane & 7;
#pragma unroll
    for (int j = 0; j < 4; ++j) { const int n = (lane >> 3) + 8 * j; const LAS float* s = scr + (8 * cch) * 33 + n;
        u32x4 o; o.x = pk2(s[0 * 33], s[1 * 33]); o.y = pk2(s[2 * 33], s[3 * 33]); o.z = pk2(s[4 * 33], s[5 * 33]); o.w = pk2(s[6 * 33], s[7 * 33]);
        *(u32x4*)(WT + (size_t)(row_off + n0 + n) * K + k0 + 8 * cch) = o; }
    asm volatile("s_waitcnt lgkmcnt(0)" ::: "memory");
}
__device__ __forceinline__ void adaln_unit(const Params& p, const Ctx& c, int unit) {
    const int i = unit / 48, n0 = (unit % 48) * 128;
    LAS float* S = (LAS float*)c.lds;
    for (int idx = c.tid; idx < 12 * D; idx += NTH) { const int r = idx >> 11, k = idx & (D - 1); const float cv = r < 4 ? p.in[2][r * D + k] : p.in[3][(r - 4) * D + k]; S[idx] = silu_f(cv); }
    __syncthreads();
    float acc[12][2];
#pragma unroll
    for (int r = 0; r < 12; ++r) { acc[r][0] = 0.f; acc[r][1] = 0.f; }
    const int kb = c.wave * 256;
    const float* W = p.in[10] + ((size_t)i * D + kb) * 6144 + n0 + 2 * c.lane;
    for (int k = 0; k < 256; k += 4) {
        f32x2 w[4];
#pragma unroll
        for (int u = 0; u < 4; ++u) w[u] = *(const f32x2*)(W + (size_t)(k + u) * 6144);
#pragma unroll
        for (int r = 0; r < 12; ++r) { const f32x4 s = *(const LAS f32x4*)(S + r * D + kb + k);
            acc[r][0] += (s.x * w[0].x + s.y * w[1].x) + (s.z * w[2].x + s.w * w[3].x); acc[r][1] += (s.x * w[0].y + s.y * w[1].y) + (s.z * w[2].y + s.w * w[3].y); }
    }
    __syncthreads();
    LAS float* P = (LAS float*)c.lds;
#pragma unroll
    for (int r = 0; r < 12; ++r) { P[(c.wave * 12 + r) * 128 + 2 * c.lane] = acc[r][0]; P[(c.wave * 12 + r) * 128 + 2 * c.lane + 1] = acc[r][1]; }
    __syncthreads();
    float* MOD = (float*)(p.ws + WS_MOD);
    for (int o = c.tid; o < 12 * 128; o += NTH) { const int r = o >> 7, n = o & 127; float s = 0.f;
#pragma unroll
        for (int w = 0; w < 8; ++w) s += P[(w * 12 + r) * 128 + n];
        MOD[(size_t)(i * 12 + r) * 6144 + n0 + n] = s + p.in[11][i * 6144 + n0 + n]; }
    __syncthreads();
}
__device__ __forceinline__ void phase_prologue(const Params& p, const Ctx& c) {
    for (int unit = c.vcu; unit < 192; unit += c.G) adaln_unit(p, c, unit);
    if (c.vcu == c.G - 1) {
        float* BIAS = (float*)(p.ws + WS_BIAS);
        for (int idx = c.tid; idx < 48 * 129; idx += NTH) { const int sh = idx / 129, j = idx % 129, g = sh >> 4, dist = j << (2 * g); int bucket;
            if (dist < 16) bucket = dist; else { const int large = 16 + (int)(log((double)dist / 16.0) / log(128.0) * 16.0); bucket = large < 31 ? large : 31; }
            BIAS[sh * 132 + j] = p.in[12][bucket * 48 + sh]; }
    }
    LAS float* scr = (LAS float*)(c.lds + c.wave * 16384);
    constexpr int I_PI = 32 * 256, I_PG = 16 * 32, I_PO = 64 * 64, I_AI = 32 * 640, I_AO = 32 * 64, I_LAYER = I_PI + 4 * I_PG + I_PO + I_AI + I_AO;
    for (int it = c.gw; it < 2 * I_LAYER; it += c.NGW) {
        const int li = it / I_LAYER; int r = it % I_LAYER;
        if (r < I_PI) { p0_transpose_item(p.in[13] + (size_t)li * D * PIN, D, PIN, (bf16*)(p.ws + WS_WPI) + (size_t)li * PIN * D, 0, scr, r, c.lane); continue; } r -= I_PI;
        if (r < 4 * I_PG) { const int g = r / I_PG; p0_transpose_item(p.in[14] + (size_t)(li * 4 + g) * 1024 * 1024, 1024, 1024, (bf16*)(p.ws + WS_WPG) + (size_t)li * PW * 1024, g * 1024, scr, r % I_PG, c.lane); continue; } r -= 4 * I_PG;
        if (r < I_PO) { p0_transpose_item(p.in[16] + (size_t)li * PW * D, PW, D, (bf16*)(p.ws + WS_WPO) + (size_t)li * D * PW, 0, scr, r, c.lane); continue; } r -= I_PO;
        if (r < I_AI) { p0_transpose_item(p.in[17] + (size_t)li * D * AIN, D, AIN, (bf16*)(p.ws + WS_WAI) + (size_t)li * AIN * D, 0, scr, r, c.lane); continue; } r -= I_AI;
        p0_transpose_item(p.in[18] + (size_t)li * D * D, D, D, (bf16*)(p.ws + WS_WAO) + (size_t)li * D * D, 0, scr, r, c.lane);
    }
}

__device__ __forceinline__ void phase_norm(const Params& p, const Ctx& c, int i) {
    const float* MOD = (const float*)(p.ws + WS_MOD); const float* Y = (const float*)(p.ws + WS_Y); bf16* H = (bf16*)(p.ws + WS_H);
    for (int row = c.gw; row < MROWS + NS; row += c.NGW) {
        const bool smp = row >= MROWS; const int b = smp ? row - MROWS : row >> 11, mr = smp ? 4 + b : b;
        float* xo = smp ? p.out + O_YS + (size_t)b * D : p.out + O_YP + (size_t)row * D;
        const float* xi = (i <= 1) ? (smp ? p.in[1] + (size_t)b * D : p.in[0] + (size_t)row * D) : xo;
        f32x4 v[8];
#pragma unroll
        for (int j = 0; j < 8; ++j) v[j] = ((const f32x4*)xi)[c.lane + 64 * j];
        if (i > 0) {
            f32x4 y[8]; float ss = 0.f;
#pragma unroll
            for (int j = 0; j < 8; ++j) { y[j] = ((const f32x4*)(Y + (size_t)row * D))[c.lane + 64 * j]; ss += (y[j].x * y[j].x + y[j].y * y[j].y) + (y[j].z * y[j].z + y[j].w * y[j].w); }
            const float rstd = 1.0f / sqrtf(wave_sum(ss) * (1.0f / D) + RMS_EPS);
            const f32x4* gate = (const f32x4*)(MOD + (size_t)((i - 1) * 12 + mr) * 6144 + 4096); const f32x4* npo = (const f32x4*)(p.in[9] + (size_t)(i - 1) * D);
#pragma unroll
            for (int j = 0; j < 8; ++j) { const f32x4 g4 = gate[c.lane + 64 * j], n4 = npo[c.lane + 64 * j]; v[j] = v[j] + g4 * (y[j] * rstd * n4); ((f32x4*)xo)[c.lane + 64 * j] = v[j]; }
        }
        if (i < 4) {
            float ss = 0.f;
#pragma unroll
            for (int j = 0; j < 8; ++j) ss += (v[j].x * v[j].x + v[j].y * v[j].y) + (v[j].z * v[j].z + v[j].w * v[j].w);
            const float rstd = 1.0f / sqrtf(wave_sum(ss) * (1.0f / D) + RMS_EPS);
            const f32x4* sh = (const f32x4*)(MOD + (size_t)(i * 12 + mr) * 6144); const f32x4* sc = sh + 512; const f32x4* npr = (const f32x4*)(p.in[8] + (size_t)i * D);
            u32x2* ho = (u32x2*)(H + (size_t)row * D);
#pragma unroll
            for (int j = 0; j < 8; ++j) { const f32x4 s4 = sc[c.lane + 64 * j], h4 = sh[c.lane + 64 * j], n4 = npr[c.lane + 64 * j]; const f32x4 h = v[j] * rstd * n4 * (1.0f + s4) + h4;
                u32x2 w; w.x = pk2(h.x, h.y); w.y = pk2(h.z, h.w); ho[c.lane + 64 * j] = w; }
        }
    }
}

__device__ __forceinline__ void phase_window(const Params& p, const Ctx& c, int li) {
    const bf16* proj = (const bf16*)(p.ws + WS_PROJ); bf16* R = (bf16*)(p.ws + WS_R);
    for (int task = c.vcu * NTH + c.tid; task < MROWS * 512; task += c.G * NTH) {
        const int row = task >> 9, col = (task & 511) * 8, w = 2 << (col >> 10), t = row & (SEQ - 1), n = (t + 1) < w ? (t + 1) : w;
        const bf16* up = proj + (size_t)row * PIN + col;
        const u32x4 u0 = *(const u32x4*)up;
        float a[8] = {bflo(u0.x), bfhi(u0.x), bflo(u0.y), bfhi(u0.y), bflo(u0.z), bfhi(u0.z), bflo(u0.w), bfhi(u0.w)};
        float s[8];
#pragma unroll
        for (int e = 0; e < 8; ++e) s[e] = a[e];
        for (int k = 1; k < n; ++k) { const u32x4 x = *(const u32x4*)(up - (size_t)k * PIN);
            s[0] += bflo(x.x); s[1] += bfhi(x.x); s[2] += bflo(x.y); s[3] += bfhi(x.y); s[4] += bflo(x.z); s[5] += bfhi(x.z); s[6] += bflo(x.w); s[7] += bfhi(x.w); }
        const float inv = 1.0f / (float)n;
        u32x4 o; o.x = pk2(s[0] * inv - a[0], s[1] * inv - a[1]); o.y = pk2(s[2] * inv - a[2], s[3] * inv - a[3]); o.z = pk2(s[4] * inv - a[4], s[5] * inv - a[5]); o.w = pk2(s[6] * inv - a[6], s[7] * inv - a[7]);
        *(u32x4*)(R + (size_t)row * PW + col) = o;
    }
    const float* PS = (const float*)(p.ws + WS_PS); bf16* RS = (bf16*)(p.ws + WS_RS);
    for (int task = c.vcu * NTH + c.tid; task < NS * PW; task += c.G * NTH) {
        const int s = task >> 12, col = task & (PW - 1), w = 2 << (col >> 10);
        const float* st = p.in[7] + ((size_t)(li * NS + s) * 15) * PW + col; float* po = p.out + O_POOLS + ((size_t)(li * NS + s) * 15) * PW + col;
        const float un = PS[(size_t)s * PIN + col]; float sum = un;
        for (int j = 16 - w; j < 15; ++j) sum += st[(size_t)j * PW];
        for (int j = 0; j < 14; ++j) po[(size_t)j * PW] = st[(size_t)(j + 1) * PW];
        po[(size_t)14 * PW] = un;
        RS[(size_t)s * PW + col] = (bf16)f2bf(sum / (float)w - un);
    }
}

__device__ __forceinline__ void phase_attention_naive(const Params& p, const Ctx& c, int li) {
    const bf16* proj = (const bf16*)(p.ws + WS_PROJ); const float* BIAS = (const float*)(p.ws + WS_BIAS); bf16* A2 = (bf16*)(p.ws + WS_A3);
    LAS float* qs = (LAS float*)(c.lds + c.wave * 2048); LAS float* ps = qs + 128;
    for (int task = c.gw; task < MROWS * 16; task += c.NGW) {
        const int row = task >> 4, h = task & 15, t = row & (SEQ - 1);
        float og0[3], og1[3], lse[3];
#pragma unroll
        for (int g = 0; g < 3; ++g) {
            const int dil = 1 << (2 * g), nk = (t / dil) < 128 ? (t / dil) : 128;
            { const unsigned qw = *(const unsigned*)(proj + (size_t)row * AIN + g * 2048 + h * 128 + 2 * c.lane); qs[2 * c.lane] = bflo(qw); qs[2 * c.lane + 1] = bfhi(qw); }
            asm volatile("s_waitcnt lgkmcnt(0)" ::: "memory");
            float s[3], pj[3];
#pragma unroll
            for (int jj = 0; jj < 3; ++jj) {
                const int j = c.lane + 64 * jj; const bool valid = (jj < 2 || c.lane == 0) && j <= nk; float sc = NEG_INF;
                if (valid) { const bf16* kp = proj + (size_t)(row - j * dil) * AIN + QKVW + g * 2048 + h * 128; float dot = 0.f;
#pragma unroll
                    for (int ch = 0; ch < 16; ++ch) { const u32x4 kv = *(const u32x4*)(kp + 8 * ch); const f32x4 q0 = *(const LAS f32x4*)(qs + 8 * ch), q1 = *(const LAS f32x4*)(qs + 8 * ch + 4);
                        dot += (bflo(kv.x) * q0.x + bfhi(kv.x) * q0.y) + (bflo(kv.y) * q0.z + bfhi(kv.y) * q0.w) + (bflo(kv.z) * q1.x + bfhi(kv.z) * q1.y) + (bflo(kv.w) * q1.z + bfhi(kv.w) * q1.w); }
                    sc = dot * ATT_SCALE + BIAS[(g * 16 + h) * 132 + j]; }
                s[jj] = sc;
            }
            const float m = wave_max(fmaxf(fmaxf(s[0], s[1]), s[2]));
            float lsum = 0.f;
#pragma unroll
            for (int jj = 0; jj < 3; ++jj) { const int j = c.lane + 64 * jj; const bool valid = (jj < 2 || c.lane == 0) && j <= nk; pj[jj] = valid ? __expf(s[jj] - m) : 0.f; lsum += pj[jj]; if (jj < 2 || c.lane == 0) ps[j] = pj[jj]; }
            const float l = wave_sum(lsum);
            asm volatile("s_waitcnt lgkmcnt(0)" ::: "memory");
            float o0 = 0.f, o1 = 0.f;
            for (int j = 0; j <= nk; ++j) { const float pv = ps[j]; const unsigned vw = *(const unsigned*)(proj + (size_t)(row - j * dil) * AIN + 2 * QKVW + g * 2048 + h * 128 + 2 * c.lane); o0 += pv * bflo(vw); o1 += pv * bfhi(vw); }
            og0[g] = o0 / l; og1[g] = o1 / l; lse[g] = m + __logf(l);
            asm volatile("s_waitcnt lgkmcnt(0)" ::: "memory");
        }
        const float mm = fmaxf(fmaxf(lse[0], lse[1]), lse[2]); const float w0 = __expf(lse[0] - mm), w1 = __expf(lse[1] - mm), w2 = __expf(lse[2] - mm), wi = 1.0f / (w0 + w1 + w2);
        const unsigned zw = *(const unsigned*)(proj + (size_t)row * AIN + 3 * QKVW + h * 128 + 2 * c.lane);
        const float r0 = (w0 * og0[0] + w1 * og0[1] + w2 * og0[2]) * wi * silu_f(bflo(zw)), r1 = (w0 * og1[0] + w1 * og1[1] + w2 * og1[2]) * wi * silu_f(bfhi(zw));
        *(unsigned*)(A2 + (size_t)row * D + h * 128 + 2 * c.lane) = pk2(r0, r1);
    }
}
__device__ __forceinline__ void phase_attention_sample(const Params& p, const Ctx& c, int li) {
    const float* PS = (const float*)(p.ws + WS_PS); const float* BIAS = (const float*)(p.ws + WS_BIAS); bf16* A2S = (bf16*)(p.ws + WS_A3S);
    LAS float* qs = (LAS float*)(c.lds + c.wave * 2048); LAS float* ps = qs + 128;
    for (int task = c.gw; task < NS * 16; task += c.NGW) {
        const int b = task >> 4, h = task & 15;
        float og0[3], og1[3], lse[3];
#pragma unroll
        for (int g = 0; g < 3; ++g) {
            const int dil = 1 << (2 * g), L = 128 << (2 * g);
            const float* cache = p.in[4 + g] + ((size_t)(li * NS + b) * L) * 4096 + h * 128;
            const float* qp = PS + (size_t)b * AIN + g * 2048 + h * 128;
            qs[2 * c.lane] = qp[2 * c.lane]; qs[2 * c.lane + 1] = qp[2 * c.lane + 1];
            asm volatile("s_waitcnt lgkmcnt(0)" ::: "memory");
            float s[3], pj[3];
#pragma unroll
            for (int jj = 0; jj < 3; ++jj) {
                const int j = c.lane + 64 * jj; const bool valid = (jj < 2 || c.lane == 0); float sc = NEG_INF;
                if (valid) { const float* kp = j == 0 ? PS + (size_t)b * AIN + QKVW + g * 2048 + h * 128 : cache + (size_t)(L - j * dil) * 4096; float dot = 0.f;
#pragma unroll 8
                    for (int ch = 0; ch < 32; ++ch) { const f32x4 kv = *(const f32x4*)(kp + 4 * ch); const f32x4 q0 = *(const LAS f32x4*)(qs + 4 * ch); dot += (kv.x * q0.x + kv.y * q0.y) + (kv.z * q0.z + kv.w * q0.w); }
                    sc = dot * ATT_SCALE + BIAS[(g * 16 + h) * 132 + j]; }
                s[jj] = sc;
            }
            const float m = wave_max(fmaxf(fmaxf(s[0], s[1]), s[2]));
            float lsum = 0.f;
#pragma unroll
            for (int jj = 0; jj < 3; ++jj) { const int j = c.lane + 64 * jj; const bool valid = (jj < 2 || c.lane == 0); pj[jj] = valid ? __expf(s[jj] - m) : 0.f; lsum += pj[jj]; if (valid) ps[j] = pj[jj]; }
            const float l = wave_sum(lsum);
            asm volatile("s_waitcnt lgkmcnt(0)" ::: "memory");
            float o0 = 0.f, o1 = 0.f;
            for (int j = 0; j <= 128; ++j) { const float pv = ps[j]; const float* vp = j == 0 ? PS + (size_t)b * AIN + 2 * QKVW + g * 2048 + h * 128 : cache + (size_t)(L - j * dil) * 4096 + 2048;
                const f32x2 vv = *(const f32x2*)(vp + 2 * c.lane); o0 += pv * vv.x; o1 += pv * vv.y; }
            og0[g] = o0 / l; og1[g] = o1 / l; lse[g] = m + __logf(l);
            asm volatile("s_waitcnt lgkmcnt(0)" ::: "memory");
        }
        const float mm = fmaxf(fmaxf(lse[0], lse[1]), lse[2]); const float w0 = __expf(lse[0] - mm), w1 = __expf(lse[1] - mm), w2 = __expf(lse[2] - mm), wi = 1.0f / (w0 + w1 + w2);
        const f32x2 z = *(const f32x2*)(PS + (size_t)b * AIN + 3 * QKVW + h * 128 + 2 * c.lane);
        const float r0 = (w0 * og0[0] + w1 * og0[1] + w2 * og0[2]) * wi * silu_f(z.x), r1 = (w0 * og1[0] + w1 * og1[1] + w2 * og1[2]) * wi * silu_f(z.y);
        *(unsigned*)(A2S + (size_t)b * D + h * 128 + 2 * c.lane) = pk2(r0, r1);
    }
}

__global__ void __launch_bounds__(NTH, 2) mega_fwd(Params p) {
    extern __shared__ __attribute__((aligned(16))) unsigned char lds_raw[];
    Ctx c;
    c.lds = (LAS unsigned char*)lds_raw;
    c.tid = threadIdx.x; c.lane = c.tid & 63; c.wave = __builtin_amdgcn_readfirstlane(c.tid >> 6);
    c.G = gridDim.x; { const int bx = blockIdx.x; c.vcu = (c.G % 8 == 0) ? (bx % 8) * (c.G / 8) + bx / 8 : bx; }
    c.gw = c.vcu * NWAVES + c.wave; c.NGW = c.G * NWAVES;
    volatile LAS unsigned* MISC = (volatile LAS unsigned*)(c.lds + MISC_OFF);
    for (int u = c.tid; u < (LDS_BYTES - LDSCTL_OFF) / 4; u += NTH) ((LAS unsigned*)(c.lds + LDSCTL_OFF))[u] = 0u;
    __syncthreads();
    unsigned* ctl = (unsigned*)(p.ws + WS_CTL);
    XcdBarrier bar; bar.bar = ctl + CW_BAR; bar.x = 0; bar.st = nullptr;
    const int lo = p.ph_lo, hi = p.ph_hi;
    if (hi - lo > 1) bar = xcd_barrier_post(ctl + CW_BAR, MISC + 8);
#define IN(k) (lo <= (k) && (k) < hi)
#define SEAM(k) do { if (IN(k) && IN((k) + 1)) xcd_barrier(bar); } while (0)
    bf16* const H = (bf16*)(p.ws + WS_H); bf16* const PROJ = (bf16*)(p.ws + WS_PROJ); bf16* const R = (bf16*)(p.ws + WS_R); bf16* const A3 = (bf16*)(p.ws + WS_A3);
    float* const Y = (float*)(p.ws + WS_Y); float* const PS = (float*)(p.ws + WS_PS); bf16* const RS = (bf16*)(p.ws + WS_RS); bf16* const A3S = (bf16*)(p.ws + WS_A3S);

    if (IN(0)) phase_prologue(p, c);
    SEAM(0);
    const Ctx c0 = c;
    for (int i = 0; i < 4; ++i) {
        const int ph = 1 + 5 * i, li = i >> 1;
        Ctx c = c0; asm volatile("" : "+v"(c.tid), "+v"(c.lane));
        if (IN(ph)) phase_norm(p, c, i);
        SEAM(ph);
        if (!(i & 1)) {
            const bf16* Wpi = (const bf16*)(p.ws + WS_WPI) + (size_t)li * PIN * D; const bf16* Wpg = (const bf16*)(p.ws + WS_WPG) + (size_t)li * PW * 1024; const bf16* Wpo = (const bf16*)(p.ws + WS_WPO) + (size_t)li * D * PW;
            if (IN(ph + 1)) {
                sgemm8(c, H + (size_t)MROWS * D, D, 0, Wpi, PIN, D, [&](int s, int n, float v) { PS[(size_t)s * PIN + n] = v; });
                run_gemm<0>(c, pg8::Gemm{H, Wpi, MROWS, PIN, D, D, 0}, StG1p{PROJ, p.out + O_POOLP + (size_t)li * 4 * 15 * PW});
            }
            SEAM(ph + 1);
            if (IN(ph + 2)) phase_window(p, c, li);
            SEAM(ph + 2);
            if (IN(ph + 3)) {
                const float* scale = p.in[15] + (size_t)li * PW;
                sgemm8(c, RS, PW, 1024, Wpg, PW, 1024, [&](int s, int n, float v) { A3S[(size_t)s * PW + n] = (bf16)f2bf(v * scale[n] * silu_f(PS[(size_t)s * PIN + PW + n])); });
                run_gemm<1>(c, pg8::Gemm{R, Wpg, MROWS, PW, 1024, PW, 4}, StG2p{PROJ, scale, A3});
            }
            SEAM(ph + 3);
            if (IN(ph + 4)) {
                sgemm8(c, A3S, PW, 0, Wpo, D, PW, [&](int s, int n, float v) { Y[(size_t)(MROWS + s) * D + n] = v; });
                run_gemm<2>(c, pg8::Gemm{A3, Wpo, MROWS, D, PW, PW, 0}, StF32{Y, D});
            }
            SEAM(ph + 4);
        } else {
            const bf16* Wai = (const bf16*)(p.ws + WS_WAI) + (size_t)li * AIN * D; const bf16* Wao = (const bf16*)(p.ws + WS_WAO) + (size_t)li * D * D;
            if (IN(ph + 1)) {
                float* const out = p.out;
                sgemm8(c, H + (size_t)MROWS * D, D, 0, Wai, AIN, D, [&](int s, int n, float v) {
                    PS[(size_t)s * AIN + n] = v;
                    if (n >= QKVW && n < 3 * QKVW) { int cc = n - QKVW; const int kv = cc >= QKVW ? 1 : 0; cc -= kv * QKVW; const int g = cc >> 11, he = cc & 2047;
                        const size_t base = g == 0 ? O_KV0S : (g == 1 ? O_KV1S : O_KV2S); out[base + (size_t)(li * NS + s) * 4096 + kv * 2048 + he] = v; } });
                run_gemm<3>(c, pg8::Gemm{H, Wai, MROWS, AIN, D, D, 0}, StG1a{PROJ, p.out, li});
            }
            SEAM(ph + 1);
            if (IN(ph + 2)) { phase_attention_naive(p, c, li); phase_attention_sample(p, c, li); }
            SEAM(ph + 2);
            if (IN(ph + 3)) { }
            if (IN(ph + 4)) {
                sgemm8(c, A3S, D, 0, Wao, D, D, [&](int s, int n, float v) { Y[(size_t)(MROWS + s) * D + n] = v; });
                run_gemm<4>(c, pg8::Gemm{A3, Wao, MROWS, D, D, D, 0}, StF32{Y, D});
            }
            SEAM(ph + 4);
        }
    }
    if (IN(21)) phase_norm(p, c, 4);
#undef IN
#undef SEAM
}

extern "C" void kernel_launch(void* const* d_in, const int* in_sizes, int n_in, void* d_out, int out_size, void* d_ws, size_t ws_size, hipStream_t stream) {
    static int grid = 0;
    if (grid == 0) {
        if (n_in != 19 || (size_t)out_size != O_END || ws_size < WS_END) { fprintf(stderr, "kernel_launch: unexpected shapes: n_in %d out %d ws %zu; nothing launched\n", n_in, out_size, ws_size); grid = -1; return; }
        int dev = 0, cus = 0, per_cu = 0;
        if (hipGetDevice(&dev) != hipSuccess || hipDeviceGetAttribute(&cus, hipDeviceAttributeMultiprocessorCount, dev) != hipSuccess) { fprintf(stderr, "kernel_launch: device query failed\n"); grid = -1; return; }
        if (hipFuncSetAttribute((const void*)mega_fwd, hipFuncAttributeMaxDynamicSharedMemorySize, LDS_BYTES) != hipSuccess) { fprintf(stderr, "kernel_launch: hipFuncSetAttribute failed\n"); grid = -1; return; }
        if (hipOccupancyMaxActiveBlocksPerMultiprocessor(&per_cu, (const void*)mega_fwd, NTH, LDS_BYTES) != hipSuccess || per_cu < 1) fprintf(stderr, "kernel_launch: occupancy query reports %d workgroups per CU\n", per_cu);
        (void)hipGetLastError();
        grid = cus;
    }
    if (grid < 0) return;
    if (hipMemsetAsync((char*)d_ws + WS_CTL, 0, CTL_ZERO_BYTES, stream) != hipSuccess) { fprintf(stderr, "kernel_launch: memset failed\n"); return; }
    Params p{};
    for (int i = 0; i < 19; ++i) p.in[i] = (const float*)d_in[i];
    p.out = (float*)d_out; p.ws = (unsigned char*)d_ws;
#if MK_ONE_LAUNCH
    p.ph_lo = 0; p.ph_hi = N_PHASES;
    hipLaunchKernelGGL(mega_fwd, dim3(grid), dim3(NTH), LDS_BYTES, stream, p);
#else
    for (int ph = 0; ph < N_PHASES; ++ph) {
        if (ph >= 1 && ph < 21 && ((ph - 1) % 5) == 3 && (((ph - 1) / 5) & 1)) continue;
        p.ph_lo = ph; p.ph_hi = ph + 1;
        hipLaunchKernelGGL(mega_fwd, dim3(grid), dim3(NTH), LDS_BYTES, stream, p);
    }
#endif
    const hipError_t le = hipPeekAtLastError();
    if (le != hipSuccess) fprintf(stderr, "kernel_launch: launch failed: %s\n", hipGetErrorName(le));
}
```

```cpp
#include <hip/hip_runtime.h>
#include <cstdio>
#include <cstdint>
#define GAS __attribute__((address_space(1)))
#define LAS __attribute__((address_space(3)))
namespace pg8 {
#define PG8_LAS __attribute__((address_space(3)))
typedef unsigned short bf16_t;
typedef short bf16x8 __attribute__((ext_vector_type(8)));
typedef float f32x4 __attribute__((ext_vector_type(4)));
typedef unsigned u32x4 __attribute__((ext_vector_type(4)));
constexpr int BM = 256, BK = 64, HALF = 128, HTB = HALF * BK * 2  , STAGE_BYTES = 8 * HTB, NXCD = 8, WGM = 8;

__host__ __device__ __forceinline__ int lds_byte(int r, int c) { const int st = (r >> 4) * 2 + (c >> 5), rr = r & 15, cc = c & 31, ob = rr * 64 + cc * 2; return st * 1024 + (ob ^ (((ob >> 9) & 1) << 5)); }
__host__ __device__ __forceinline__ void stage_rc(int b, int& R, int& C) { const int st = b / 1024, sb = b % 1024, swz = sb ^ (((sb >> 9) & 1) << 5); R = (st >> 1) * 16 + swz / 64; C = (st & 1) * 32 + (swz % 64) / 2; }
__host__ __device__ __forceinline__ int perm32(int rho) { const int n = rho >> 4, i = rho & 15; return 8 * (i >> 2) + 4 * n + (i & 3); }

struct Unit { int pm, pn; };
struct Gemm { const bf16_t* A; const bf16_t* Bt; int M, N, K, lda, agrp; };

struct StaticOrder {
    int nM, nN, nwg, G, c;
    __host__ __device__ void init(int M, int N, int G_, int c_) { nM = M / BM; nN = N / BM; nwg = nM * nN; G = G_; c = c_; }
    __host__ __device__ bool next(int i, Unit& u) const {
        const long L = (long)i * G + c; if (L >= nwg) return false;
        int wgid = (int)L; { const int q = nwg / NXCD, r = nwg % NXCD, xcd = wgid % NXCD, off = wgid / NXCD; wgid = (xcd < r ? xcd * (q + 1) : r * (q + 1) + (xcd - r) * q) + off; }
        const int nig = WGM * nN, gid = wgid / nig, fm = gid * WGM, gsz = (nM - fm) < WGM ? (nM - fm) : WGM;
        u.pm = fm + ((wgid % nig) % gsz); u.pn = (wgid % nig) / gsz; return true;
    }
    __device__ __forceinline__ void a_ready(const Unit&) const {}
    __device__ __forceinline__ void done(const Unit&) const {}
};

template <class Epi, class Sched, bool ALIGN_EPI = false, bool SP2 = false>
__device__ __forceinline__ void gemm_phase(PG8_LAS unsigned char* lds, const Gemm g, const Sched& S, const Epi& E) {
    int tid = threadIdx.x; asm volatile("" : "+v"(tid));
    const int wid = __builtin_amdgcn_readfirstlane(tid >> 6), lane = tid & 63, wr = wid >> 2, wc = wid & 3, fr = lane & 15, fq = lane >> 4;
    const int K = g.K, nt = K / BK;
    unsigned voffA[2], voffB[2];
#pragma unroll
    for (int i = 0; i < 2; ++i) { int R, C; stage_rc(tid * 16 + i * 8192, R, C); const int Rb = Epi::PERM ? ((R & ~31) + perm32(R & 31)) : R;
        voffA[i] = (unsigned)(R * g.lda + C) * 2u; voffB[i] = (unsigned)(Rb * K + C) * 2u; }
    const size_t kstep = (size_t)(BK * 2);
    const size_t hstepB = (size_t)HALF * K * 2, hstepA = (size_t)HALF * g.lda * 2;
    const size_t tstepB = 2 * hstepB, tstepA = 2 * hstepA;
    const unsigned ldsw = (unsigned)wid * 1024u;
    const int aoff = lds_byte(wr * 64 + fr, fq * 8), boff = lds_byte(wc * 32 + fr, fq * 8);
#define PG8_SA(b, h) (((b) * 2 + (h)) * HTB)
#define PG8_SB(b, h) ((4 + (b) * 2 + (h)) * HTB)
#define PG8_STAGE(bufoff, gbase, voff) do { _Pragma("unroll") for (int _i = 0; _i < 2; ++_i) \
        __builtin_amdgcn_global_load_lds((const unsigned*)((const char*)(gbase) + (voff)[_i]), (PG8_LAS unsigned*)(lds + (bufoff) + ldsw + _i * 8192), 16, 0, 0); } while (0)
#define PG8_LDA(dst, b, h) do { _Pragma("unroll") for (int m = 0; m < 4; ++m) _Pragma("unroll") for (int k = 0; k < 2; ++k) dst[m][k] = *(const PG8_LAS bf16x8*)(lds + PG8_SA(b, h) + aoff + m * 2048 + k * 1024); } while (0)
#define PG8_LDB(dst, b, h) do { _Pragma("unroll") for (int n = 0; n < 2; ++n) _Pragma("unroll") for (int k = 0; k < 2; ++k) dst[n][k] = *(const PG8_LAS bf16x8*)(lds + PG8_SB(b, h) + boff + n * 2048 + k * 1024); } while (0)
#define PG8_MMA(ai, bj, At, Bt) do { __builtin_amdgcn_s_setprio(1); _Pragma("unroll") for (int m = 0; m < 4; ++m) _Pragma("unroll") for (int n = 0; n < 2; ++n) _Pragma("unroll") for (int k = 0; k < 2; ++k) \
        acc[ai][bj][m][n] = __builtin_amdgcn_mfma_f32_16x16x32_bf16(Bt[n][k], At[m][k], acc[ai][bj][m][n], 0, 0, 0); __builtin_amdgcn_s_setprio(0); } while (0)
#define PG8_WAIT_V(n) asm volatile("s_waitcnt vmcnt(" #n ")" ::: "memory")
#define PG8_WAIT_L(n) asm volatile("s_waitcnt lgkmcnt(" #n ")" ::: "memory")
#define PG8_BAR __builtin_amdgcn_s_barrier()
#define PG8_SCHED __builtin_amdgcn_sched_barrier(0)
    Unit cur, nxt; int ui = 0;
    if (!S.next(0, cur)) return;
    f32x4 acc[2][2][4][2];
#pragma unroll
    for (int a = 0; a < 2; ++a)
#pragma unroll
        for (int b = 0; b < 2; ++b)
#pragma unroll
            for (int m = 0; m < 4; ++m)
#pragma unroll
                for (int n = 0; n < 2; ++n) acc[a][b][m][n] = (f32x4){0.f, 0.f, 0.f, 0.f};
    bf16x8 At[4][2], B0[2][2], B1[2][2];
    const char* cA = (const char*)g.A + (size_t)cur.pm * tstepA + (g.agrp ? (size_t)(cur.pn / g.agrp) * K * 2 : (size_t)0); const char* cB = (const char*)g.Bt + (size_t)cur.pn * tstepB;
    S.a_ready(cur);
    if constexpr (SP2) {
        PG8_STAGE(PG8_SB(0, 0), cB, voffB); PG8_STAGE(PG8_SB(0, 1), cB + hstepB, voffB); PG8_STAGE(PG8_SA(0, 0), cA, voffA); PG8_STAGE(PG8_SA(0, 1), cA + hstepA, voffA);
        if (wr == 1) PG8_BAR;
        PG8_WAIT_V(2); PG8_BAR;
        PG8_STAGE(PG8_SB(1, 0), cB + kstep, voffB); PG8_STAGE(PG8_SA(1, 0), cA + kstep, voffA); PG8_STAGE(PG8_SB(1, 1), cB + hstepB + kstep, voffB);
        PG8_WAIT_V(6); PG8_BAR;
    } else {
        PG8_STAGE(PG8_SB(0, 0), cB, voffB); PG8_STAGE(PG8_SA(0, 0), cA, voffA); PG8_STAGE(PG8_SB(0, 1), cB + hstepB, voffB); PG8_STAGE(PG8_SA(0, 1), cA + hstepA, voffA);
        if (wr == 1) PG8_BAR;
        PG8_WAIT_V(4); PG8_BAR;
        PG8_STAGE(PG8_SB(1, 0), cB + kstep, voffB); PG8_STAGE(PG8_SA(1, 0), cA + kstep, voffA); PG8_STAGE(PG8_SB(1, 1), cB + hstepB + kstep, voffB);
        PG8_WAIT_V(6); PG8_BAR;
    }
    for (;;) {
        const bool has_next = S.next(ui + 1, nxt);
        const char* nA = has_next ? (const char*)g.A + (size_t)nxt.pm * tstepA + (g.agrp ? (size_t)(nxt.pn / g.agrp) * K * 2 : (size_t)0) : cA; const char* nB = has_next ? (const char*)g.Bt + (size_t)nxt.pn * tstepB : cB;
        for (int t = 0; t < nt; t += 2) {
            const bool last = (t == nt - 2);
            const char* a1 = cA + (size_t)(t + 1) * kstep;
            const char* a2 = last ? nA : cA + (size_t)(t + 2) * kstep; const char* b2 = last ? nB : cB + (size_t)(t + 2) * kstep;
            const char* a3 = a2 + kstep; const char* b3 = b2 + kstep;
            if (last && has_next) S.a_ready(nxt);
            if constexpr (SP2) {
            PG8_LDB(B0, 0, 0); PG8_LDB(B1, 0, 1); PG8_SCHED; PG8_LDA(At, 0, 0); PG8_STAGE(PG8_SA(1, 1), a1 + hstepA, voffA);
            PG8_WAIT_V(8); PG8_WAIT_L(0); PG8_BAR; PG8_MMA(0, 0, At, B0); PG8_MMA(0, 1, At, B1); PG8_BAR; PG8_SCHED;
            PG8_LDA(At, 0, 1); PG8_STAGE(PG8_SB(0, 0), b2, voffB); PG8_STAGE(PG8_SB(0, 1), b2 + hstepB, voffB); PG8_STAGE(PG8_SA(0, 0), a2, voffA);
            PG8_WAIT_V(8); PG8_WAIT_L(0); PG8_BAR; PG8_MMA(1, 0, At, B0); PG8_MMA(1, 1, At, B1); PG8_BAR; PG8_SCHED;
            PG8_LDB(B0, 1, 0); PG8_LDB(B1, 1, 1); PG8_SCHED; PG8_LDA(At, 1, 0); PG8_STAGE(PG8_SA(0, 1), a2 + hstepA, voffA);
            PG8_WAIT_V(8); PG8_WAIT_L(0); PG8_BAR; PG8_MMA(0, 0, At, B0); PG8_MMA(0, 1, At, B1); PG8_BAR; PG8_SCHED;
            PG8_LDA(At, 1, 1); PG8_STAGE(PG8_SB(1, 0), b3, voffB); PG8_STAGE(PG8_SB(1, 1), b3 + hstepB, voffB); PG8_STAGE(PG8_SA(1, 0), a3, voffA);
            PG8_WAIT_V(8); PG8_WAIT_L(0); PG8_BAR; PG8_MMA(1, 0, At, B0); PG8_MMA(1, 1, At, B1); PG8_BAR; PG8_SCHED;
            } else {
            PG8_LDB(B0, 0, 0); PG8_SCHED; PG8_LDA(At, 0, 0); PG8_STAGE(PG8_SA(1, 1), a1 + hstepA, voffA);
            PG8_WAIT_L(8); PG8_BAR; PG8_WAIT_L(0); PG8_MMA(0, 0, At, B0); PG8_BAR; PG8_SCHED;
            PG8_LDB(B1, 0, 1); PG8_STAGE(PG8_SB(0, 0), b2, voffB);
            PG8_BAR; PG8_WAIT_L(0); PG8_MMA(0, 1, At, B1); PG8_BAR;
            PG8_LDA(At, 0, 1); PG8_STAGE(PG8_SA(0, 0), a2, voffA);
            PG8_BAR; PG8_WAIT_L(0); PG8_MMA(1, 0, At, B0); PG8_BAR; PG8_SCHED;
            PG8_STAGE(PG8_SB(0, 1), b2 + hstepB, voffB);
            PG8_WAIT_V(6); PG8_BAR; PG8_MMA(1, 1, At, B1); PG8_BAR;
            PG8_LDB(B0, 1, 0); PG8_SCHED; PG8_LDA(At, 1, 0); PG8_STAGE(PG8_SA(0, 1), a2 + hstepA, voffA);
            PG8_WAIT_L(8); PG8_BAR; PG8_WAIT_L(0); PG8_MMA(0, 0, At, B0); PG8_BAR; PG8_SCHED;
            PG8_LDB(B1, 1, 1); PG8_STAGE(PG8_SB(1, 0), b3, voffB);
            PG8_BAR; PG8_WAIT_L(0); PG8_MMA(0, 1, At, B1); PG8_BAR;
            PG8_LDA(At, 1, 1); PG8_STAGE(PG8_SA(1, 0), a3, voffA);
            PG8_BAR; PG8_WAIT_L(0); PG8_MMA(1, 0, At, B0); PG8_BAR; PG8_SCHED;
            PG8_STAGE(PG8_SB(1, 1), b3 + hstepB, voffB);
            PG8_WAIT_V(6); PG8_BAR; PG8_MMA(1, 1, At, B1); PG8_BAR;
            }
        }
        if constexpr (ALIGN_EPI) { if (wr == 0) PG8_BAR; }
        if constexpr (!Epi::AFTER_DRAIN) { E(acc, cur, wr, wc, fr, fq); S.done(cur); }
        if (!has_next) break;
#pragma unroll
        for (int a = 0; a < 2; ++a)
#pragma unroll
            for (int b = 0; b < 2; ++b)
#pragma unroll
                for (int m = 0; m < 4; ++m)
#pragma unroll
                    for (int n = 0; n < 2; ++n) acc[a][b][m][n] = (f32x4){0.f, 0.f, 0.f, 0.f};
        cur = nxt; cA = nA; cB = nB; ++ui;
        if constexpr (ALIGN_EPI) { if (wr == 1) PG8_BAR; }
    }
    PG8_WAIT_V(0);
    if constexpr (!ALIGN_EPI) { if (wr == 0) PG8_BAR; }
    PG8_BAR;
    if constexpr (Epi::AFTER_DRAIN) { E.fused(acc, cur, wr, wc, fr, fq, lds, wid, lane); S.done(cur); }
#undef PG8_SA
#undef PG8_SB
#undef PG8_STAGE
#undef PG8_LDA
#undef PG8_LDB
#undef PG8_MMA
#undef PG8_WAIT_V
#undef PG8_WAIT_L
#undef PG8_BAR
#undef PG8_SCHED
}
}

#define XB_TMO      128
#define XB_XCNT(j)  (256  + 64 * (j))
#define XB_XSUB(j)  (1280 + 64 * (j))
#define XB_XGEN(j)  (2304 + 64 * (j))
#define XB_TOP      3328
#define XB_TOPGEN   3392
#define XCD_BAR_WORDS 3456
#define XB_SPIN_CAP (1u << 18)

__device__ __forceinline__ unsigned xb_ld(unsigned* p)              { return __hip_atomic_load(p, __ATOMIC_RELAXED, __HIP_MEMORY_SCOPE_AGENT); }
__device__ __forceinline__ unsigned xb_add(unsigned* p, unsigned v) { return __hip_atomic_fetch_add(p, v, __ATOMIC_RELAXED, __HIP_MEMORY_SCOPE_AGENT); }
__device__ __forceinline__ unsigned xb_xcc_id() { return (unsigned)__builtin_amdgcn_s_getreg((3 << 11) | 20) & 0xFu; }
#define XB_SPIN(cond, bar) do { unsigned _sp = 0; while (cond) { __builtin_amdgcn_s_sleep(1); \
    if ((++_sp & 255u) == 0u) { if (xb_ld(&(bar)[XB_TMO])) break; if (_sp > XB_SPIN_CAP) { atomicAdd(&(bar)[XB_TMO], 1u); break; } } } } while (0)

struct XcdBarrier {
    unsigned* bar; unsigned x;
    volatile LAS unsigned* st;
};

__device__ __forceinline__ XcdBarrier xcd_barrier_post(unsigned* bar, volatile LAS unsigned* st) {
    XcdBarrier b; b.bar = bar; b.x = xb_xcc_id(); b.st = st;
    if (threadIdx.x == 0) (void)xb_add(&bar[XB_XCNT(b.x)], 1u);
    return b;
}
__device__ __forceinline__ void xcd_barrier_complete(unsigned* bar, unsigned x, unsigned& nloc, unsigned& nx) {
    const unsigned G = gridDim.x * gridDim.y * gridDim.z;
    unsigned sum, cnt, mine, sp = 0u;
    for (;;) {
        sum = 0u; cnt = 0u; mine = 0u;
#pragma unroll
        for (unsigned j = 0; j < 16; ++j) { const unsigned c = xb_ld(&bar[XB_XCNT(j)]); sum += c; cnt += (c > 0u) ? 1u : 0u; mine = (j == x) ? c : mine; }
        if (sum == G) break;
        __builtin_amdgcn_s_sleep(1);
        if ((++sp & 255u) == 0u) { if (xb_ld(&bar[XB_TMO])) break; if (sp > XB_SPIN_CAP) { atomicAdd(&bar[XB_TMO], 1u); break; } }
    }
    nloc = mine > 0u ? mine : 1u; nx = cnt > 0u ? cnt : 1u;
}

__device__ __forceinline__ void xcd_barrier(const XcdBarrier& b) {
    asm volatile("s_waitcnt vmcnt(0)" ::: "memory");
    __syncthreads();
    if (threadIdx.x == 0) {
        unsigned* bar = b.bar;
        __builtin_amdgcn_s_waitcnt(0);
        unsigned nloc = b.st[0], nx = b.st[1];
        if (nloc == 0u) { xcd_barrier_complete(bar, b.x, nloc, nx); b.st[0] = nloc; b.st[1] = nx; }
        const unsigned old = xb_add(&bar[XB_XSUB(b.x)], 1u);
        const unsigned gen = old / nloc;
        if (old + 1u == (gen + 1u) * nloc) {
            __builtin_amdgcn_fence(__ATOMIC_RELEASE, "agent");
            asm volatile("s_waitcnt vmcnt(0)" ::: "memory");
            const unsigned og = xb_add(&bar[XB_TOP], 1u);
            const unsigned tg = og / nx;
            if (og + 1u == (tg + 1u) * nx) xb_add(&bar[XB_TOPGEN], 1u);
            else XB_SPIN(xb_ld(&bar[XB_TOPGEN]) == tg, bar);
            __builtin_amdgcn_fence(__ATOMIC_ACQUIRE, "agent");
            xb_add(&bar[XB_XGEN(b.x)], 1u);
            asm volatile("s_waitcnt vmcnt(0)" ::: "memory");
        } else {
            XB_SPIN(xb_ld(&bar[XB_XGEN(b.x)]) == gen, bar);
            __builtin_amdgcn_fence(__ATOMIC_ACQUIRE, "agent");
            asm volatile("s_waitcnt vmcnt(0)" ::: "memory");
        }
    }
    __syncthreads();
}

#ifndef MK_NAIVE_GEMM
#define MK_NAIVE_GEMM 0
#endif
#ifndef MK_NAIVE_ATT
#define MK_NAIVE_ATT 0
#endif
#ifndef MK_ONE_LAUNCH
#define MK_ONE_LAUNCH 1
#endif

constexpr int D = 2048, NB = 4, SEQ = 2048, MROWS = NB * SEQ, NS = 8;
constexpr int PW = 4096, PIN = 8192, QKVW = 6144, AIN = 20480;
constexpr int NWAVES = 8, NTH = 512;
constexpr float RMS_EPS = 1e-6f, ATT_SCALE = 0.08838834764831845f, NEG_INF = -1e30f;
constexpr size_t O_YP = 0, O_YS = O_YP + (size_t)MROWS * D, O_KV0P = O_YS + (size_t)NS * D, O_KV1P = O_KV0P + (size_t)2 * 4 * 128 * 4096, O_KV2P = O_KV1P + (size_t)2 * 4 * 512 * 4096,
                 O_POOLP = O_KV2P + (size_t)2 * 4 * 2048 * 4096, O_KV0S = O_POOLP + (size_t)2 * 4 * 15 * 4096, O_KV1S = O_KV0S + 2 * 8 * 4096, O_KV2S = O_KV1S + 2 * 8 * 4096,
                 O_POOLS = O_KV2S + 2 * 8 * 4096, O_END = O_POOLS + (size_t)2 * 8 * 15 * 4096;
static_assert(O_END == 106545152, "output size");
constexpr size_t MiB = 1u << 20;
constexpr size_t WS_CTL = 0, CTL_ZERO_BYTES = 1 * MiB;
constexpr size_t WS_MOD = 1 * MiB;
constexpr size_t WS_BIAS = 3 * MiB;
constexpr size_t WS_PS = 4 * MiB;
constexpr size_t WS_RS = 5 * MiB;
constexpr size_t WS_A3S = 6 * MiB;
constexpr size_t WS_WPI = 8 * MiB;
constexpr size_t WS_WPG = 72 * MiB;
constexpr size_t WS_WPO = 88 * MiB;
constexpr size_t WS_WAI = 120 * MiB;
constexpr size_t WS_WAO = 280 * MiB;
constexpr size_t WS_H = 296 * MiB;
constexpr size_t WS_PROJ = 330 * MiB;
constexpr size_t WS_R = 650 * MiB;
constexpr size_t WS_A3 = 714 * MiB;
constexpr size_t WS_Y = 778 * MiB;
constexpr size_t WS_OG = 844 * MiB;
constexpr size_t WS_LSE = 940 * MiB;
constexpr size_t WS_END = 942 * MiB;
constexpr int CW_BAR = 4096;
constexpr int RING_BYTES = 131072, LDSCTL_OFF = RING_BYTES, MISC_OFF = LDSCTL_OFF + 320, LDS_BYTES = 147456;
constexpr int N_PHASES = 22;

typedef unsigned short bf16;
typedef short bf16x8 __attribute__((ext_vector_type(8)));
typedef float f32x4 __attribute__((ext_vector_type(4)));
typedef float f32x2 __attribute__((ext_vector_type(2)));
typedef unsigned u32x4 __attribute__((ext_vector_type(4)));
typedef unsigned u32x2 __attribute__((ext_vector_type(2)));

__device__ __forceinline__ unsigned f2bf(float f) { unsigned u = __builtin_bit_cast(unsigned, f); return (u + 0x7fffu + ((u >> 16) & 1u)) >> 16; }
__device__ __forceinline__ unsigned pk2(float lo, float hi) { return f2bf(lo) | (f2bf(hi) << 16); }
__device__ __forceinline__ float bflo(unsigned w) { return __builtin_bit_cast(float, w << 16); }
__device__ __forceinline__ float bfhi(unsigned w) { return __builtin_bit_cast(float, w & 0xffff0000u); }
__device__ __forceinline__ float silu_f(float x) { return x / (1.0f + __expf(-x)); }
__device__ __forceinline__ float wave_sum(float v) {
#pragma unroll
    for (int o = 1; o < 64; o <<= 1) v += __shfl_xor(v, o);
    return v;
}
__device__ __forceinline__ float wave_max(float v) {
#pragma unroll
    for (int o = 1; o < 64; o <<= 1) v = fmaxf(v, __shfl_xor(v, o));
    return v;
}
__device__ __forceinline__ u32x4 pack8(const f32x4 a, const f32x4 b) { u32x4 w; w.x = pk2(a.x, a.y); w.y = pk2(a.z, a.w); w.z = pk2(b.x, b.y); w.w = pk2(b.z, b.w); return w; }
__device__ __forceinline__ float dot8(const u32x4 a, const u32x4 b) {
    return (bflo(a.x) * bflo(b.x) + bfhi(a.x) * bfhi(b.x)) + (bflo(a.y) * bflo(b.y) + bfhi(a.y) * bfhi(b.y)) + (bflo(a.z) * bflo(b.z) + bfhi(a.z) * bfhi(b.z)) + (bflo(a.w) * bflo(b.w) + bfhi(a.w) * bfhi(b.w));
}

struct Params { const float* in[19]; float* out; unsigned char* ws; int ph_lo, ph_hi; };
struct Ctx { LAS unsigned char* lds; int tid, lane, wave, vcu, G, gw, NGW; };

template <class S8> struct Epi8 {
    static constexpr bool PERM = true, AFTER_DRAIN = false;
    S8 s;
    __device__ __forceinline__ void operator()(const pg8::f32x4 (&acc)[2][2][4][2], const pg8::Unit& u, int wr, int wc, int fr, int fq) const {
        const int row0 = u.pm * 256 + wr * 64 + fr, col0 = u.pn * 256 + wc * 32 + 8 * fq;
#pragma unroll
        for (int ai = 0; ai < 2; ++ai)
#pragma unroll
            for (int m = 0; m < 4; ++m)
#pragma unroll
                for (int bj = 0; bj < 2; ++bj) s.store8(row0 + ai * 128 + m * 16, col0 + bj * 128, acc[ai][bj][m][0], acc[ai][bj][m][1]);
    }
};
struct StG1p {
    bf16* proj; float* outpool;
    __device__ __forceinline__ void store8(int row, int col, const f32x4 v0, const f32x4 v1) const {
        *(u32x4*)(proj + (size_t)row * PIN + col) = pack8(v0, v1);
        const int t = row & (SEQ - 1);
        if (col < PW && t >= SEQ - 15) { float* o = outpool + ((size_t)((row >> 11) * 15 + (t - (SEQ - 15)))) * PW + col; *(f32x4*)o = v0; *(f32x4*)(o + 4) = v1; }
    }
};
struct StG2p {
    const bf16* proj; const float* scale; bf16* a3;
    __device__ __forceinline__ void store8(int row, int col, const f32x4 v0, const f32x4 v1) const {
        const u32x4 z = *(const u32x4*)(proj + (size_t)row * PIN + PW + col);
        const f32x4 s0 = *(const f32x4*)(scale + col), s1 = *(const f32x4*)(scale + col + 4);
        f32x4 a, b;
        a.x = v0.x * s0.x * silu_f(bflo(z.x)); a.y = v0.y * s0.y * silu_f(bfhi(z.x)); a.z = v0.z * s0.z * silu_f(bflo(z.y)); a.w = v0.w * s0.w * silu_f(bfhi(z.y));
        b.x = v1.x * s1.x * silu_f(bflo(z.z)); b.y = v1.y * s1.y * silu_f(bfhi(z.z)); b.z = v1.z * s1.z * silu_f(bflo(z.w)); b.w = v1.w * s1.w * silu_f(bfhi(z.w));
        *(u32x4*)(a3 + (size_t)row * PW + col) = pack8(a, b);
    }
};
struct StF32 {
    float* C; int ldc;
    __device__ __forceinline__ void store8(int row, int col, const f32x4 v0, const f32x4 v1) const { float* o = C + (size_t)row * ldc + col; *(f32x4*)o = v0; *(f32x4*)(o + 4) = v1; }
};
struct StG1a {
    bf16* proj; float* out; int li;
    __device__ __forceinline__ void store8(int row, int col, const f32x4 v0, const f32x4 v1) const {
        *(u32x4*)(proj + (size_t)row * AIN + col) = pack8(v0, v1);
        if (col >= QKVW && col < 3 * QKVW) {
            int cc = col - QKVW; const int kv = cc >= QKVW ? 1 : 0; cc -= kv * QKVW; const int g = cc >> 11, he = cc & 2047, keep = 128 << (2 * g), t = row & (SEQ - 1), b = row >> 11;
            if (t >= SEQ - keep) {
                const size_t base = g == 0 ? O_KV0P : (g == 1 ? O_KV1P : O_KV2P);
                float* o = out + base + ((size_t)((li * 4 + b) * keep + (t - (SEQ - keep)))) * 4096 + kv * 2048 + he; *(f32x4*)o = v0; *(f32x4*)(o + 4) = v1;
            }
        }
    }
};

template <class S8> __device__ __forceinline__ void naive_gemm(const pg8::Gemm g, const S8& st, int gtid, int nth) {
    const int n8 = g.N / 8; const long total = (long)g.M * n8;
    for (long task = gtid; task < total; task += nth) {
        const int row = (int)(task % g.M), col = (int)(task / g.M) * 8;
        const bf16* a = g.A + (size_t)row * g.lda + (g.agrp ? (size_t)(col / (256 * g.agrp)) * g.K : (size_t)0);
        const bf16* b = g.Bt + (size_t)col * g.K;
        float acc[8];
#pragma unroll
        for (int c = 0; c < 8; ++c) acc[c] = 0.f;
        for (int k = 0; k < g.K; k += 8) {
            const u32x4 av = *(const u32x4*)(a + k);
#pragma unroll
            for (int c = 0; c < 8; ++c) acc[c] += dot8(av, *(const u32x4*)(b + (size_t)c * g.K + k));
        }
        st.store8(row, col, (f32x4){acc[0], acc[1], acc[2], acc[3]}, (f32x4){acc[4], acc[5], acc[6], acc[7]});
    }
}
#ifndef MK_FAST_MASK
#define MK_FAST_MASK 31
#endif
template <int SITE, class S8> __device__ __forceinline__ void run_gemm(const Ctx& c, const pg8::Gemm g, const S8& st) {
    if constexpr (MK_NAIVE_GEMM || !((MK_FAST_MASK >> SITE) & 1)) naive_gemm(g, st, (int)blockIdx.x * NTH + c.tid, c.G * NTH);
    else {
        pg8::StaticOrder S; S.init(g.M, g.N, c.G, (int)blockIdx.x);
        Epi8<S8> E{st};
        pg8::gemm_phase<Epi8<S8>, pg8::StaticOrder, true, true>((PG8_LAS unsigned char*)c.lds, g, S, E);
    }
}

template <class F> __device__ __forceinline__ void sgemm8(const Ctx& c, const bf16* As, int lda, int agrp_cols, const bf16* Wt, int N, int K, const F& epi) {
    const int q = c.lane >> 4, r = c.lane & 15;
    for (int cg = c.gw; cg < N / 16; cg += c.NGW) {
        const int n = cg * 16 + r;
        const bf16* wrow = Wt + (size_t)n * K + q * 8;
        const bf16* arow = As + (size_t)(r & 7) * lda + (agrp_cols ? ((cg * 16) / agrp_cols) * K : 0) + q * 8;
        pg8::f32x4 acc = {0.f, 0.f, 0.f, 0.f};
#pragma unroll 4
        for (int k0 = 0; k0 < K; k0 += 32) {
            bf16x8 a = *(const bf16x8*)(arow + k0); if (r >= 8) a = (bf16x8){0, 0, 0, 0, 0, 0, 0, 0};
            const bf16x8 b = *(const bf16x8*)(wrow + k0);
            acc = __builtin_amdgcn_mfma_f32_16x16x32_bf16(a, b, acc, 0, 0, 0);
        }
        if (q < 2) {
#pragma unroll
            for (int j = 0; j < 4; ++j) epi(q * 4 + j, n, acc[j]);
        }
    }
}

__device__ __forceinline__ void p0_transpose_item(const float* W, int K, int N, bf16* WT, int row_off, LAS float* scr, int item, int lane) {
    const int nblk = N / 32, kb = item / nblk, nb = item % nblk, k0 = 64 * kb, n0 = 32 * nb;
#pragma unroll 8
    for (int i = 0; i < 32; ++i) { const int kk = 2 * i + (lane >> 5); scr[kk * 33 + (lane & 31)] = W[(size_t)(k0 + kk) * N + n0 + (lane & 31)]; }
    asm volatile("s_waitcnt lgkmcnt(0)" ::: "memory");
    const int cch = lane & 7;
#pragma unroll
    for (int j = 0; j < 4; ++j) { const int n = (lane >> 3) + 8 * j; const LAS float* s = scr + (8 * cch) * 33 + n;
        u32x4 o; o.x = pk2(s[0 * 33], s[1 * 33]); o.y = pk2(s[2 * 33], s[3 * 33]); o.z = pk2(s[4 * 33], s[5 * 33]); o.w = pk2(s[6 * 33], s[7 * 33]);
        *(u32x4*)(WT + (size_t)(row_off + n0 + n) * K + k0 + 8 * cch) = o; }
    asm volatile("s_waitcnt lgkmcnt(0)" ::: "memory");
}
__device__ __forceinline__ void adaln_unit(const Params& p, const Ctx& c, int unit) {
    const int i = unit / 48, n0 = (unit % 48) * 128;
    LAS float* S = (LAS float*)c.lds;
    for (int idx = c.tid; idx < 12 * D; idx += NTH) { const int r = idx >> 11, k = idx & (D - 1); const float cv = r < 4 ? p.in[2][r * D + k] : p.in[3][(r - 4) * D + k]; S[idx] = silu_f(cv); }
    __syncthreads();
    float acc[12][2];
#pragma unroll
    for (int r = 0; r < 12; ++r) { acc[r][0] = 0.f; acc[r][1] = 0.f; }
    const int kb = c.wave * 256;
    const float* W = p.in[10] + ((size_t)i * D + kb) * 6144 + n0 + 2 * c.lane;
    for (int k = 0; k < 256; k += 4) {
        f32x2 w[4];
#pragma unroll
        for (int u = 0; u < 4; ++u) w[u] = *(const f32x2*)(W + (size_t)(k + u) * 6144);
#pragma unroll
        for (int r = 0; r < 12; ++r) { const f32x4 s = *(const LAS f32x4*)(S + r * D + kb + k);
            acc[r][0] += (s.x * w[0].x + s.y * w[1].x) + (s.z * w[2].x + s.w * w[3].x); acc[r][1] += (s.x * w[0].y + s.y * w[1].y) + (s.z * w[2].y + s.w * w[3].y); }
    }
    __syncthreads();
    LAS float* P = (LAS float*)c.lds;
#pragma unroll
    for (int r = 0; r < 12; ++r) { P[(c.wave * 12 + r) * 128 + 2 * c.lane] = acc[r][0]; P[(c.wave * 12 + r) * 128 + 2 * c.lane + 1] = acc[r][1]; }
    __syncthreads();
    float* MOD = (float*)(p.ws + WS_MOD);
    for (int o = c.tid; o < 12 * 128; o += NTH) { const int r = o >> 7, n = o & 127; float s = 0.f;
#pragma unroll
        for (int w = 0; w < 8; ++w) s += P[(w * 12 + r) * 128 + n];
        MOD[(size_t)(i * 12 + r) * 6144 + n0 + n] = s + p.in[11][i * 6144 + n0 + n]; }
    __syncthreads();
}
__device__ __forceinline__ void phase_prologue(const Params& p, const Ctx& c) {
    for (int unit = c.vcu; unit < 192; unit += c.G) adaln_unit(p, c, unit);
    if (c.vcu == c.G - 1) {
        float* BIAS = (float*)(p.ws + WS_BIAS);
        for (int idx = c.tid; idx < 48 * 129; idx += NTH) { const int sh = idx / 129, j = idx % 129, g = sh >> 4, dist = j << (2 * g); int bucket;
            if (dist < 16) bucket = dist; else { const int large = 16 + (int)(log((double)dist / 16.0) / log(128.0) * 16.0); bucket = large < 31 ? large : 31; }
            BIAS[sh * 132 + j] = p.in[12][bucket * 48 + sh]; }
    }
    LAS float* scr = (LAS float*)(c.lds + c.wave * 16384);
    constexpr int I_PI = 32 * 256, I_PG = 16 * 32, I_PO = 64 * 64, I_AI = 32 * 640, I_AO = 32 * 64, I_LAYER = I_PI + 4 * I_PG + I_PO + I_AI + I_AO;
    for (int it = c.gw; it < 2 * I_LAYER; it += c.NGW) {
        const int li = it / I_LAYER; int r = it % I_LAYER;
        if (r < I_PI) { p0_transpose_item(p.in[13] + (size_t)li * D * PIN, D, PIN, (bf16*)(p.ws + WS_WPI) + (size_t)li * PIN * D, 0, scr, r, c.lane); continue; } r -= I_PI;
        if (r < 4 * I_PG) { const int g = r / I_PG; p0_transpose_item(p.in[14] + (size_t)(li * 4 + g) * 1024 * 1024, 1024, 1024, (bf16*)(p.ws + WS_WPG) + (size_t)li * PW * 1024, g * 1024, scr, r % I_PG, c.lane); continue; } r -= 4 * I_PG;
        if (r < I_PO) { p0_transpose_item(p.in[16] + (size_t)li * PW * D, PW, D, (bf16*)(p.ws + WS_WPO) + (size_t)li * D * PW, 0, scr, r, c.lane); continue; } r -= I_PO;
        if (r < I_AI) { p0_transpose_item(p.in[17] + (size_t)li * D * AIN, D, AIN, (bf16*)(p.ws + WS_WAI) + (size_t)li * AIN * D, 0, scr, r, c.lane); continue; } r -= I_AI;
        p0_transpose_item(p.in[18] + (size_t)li * D * D, D, D, (bf16*)(p.ws + WS_WAO) + (size_t)li * D * D, 0, scr, r, c.lane);
    }
}

__device__ __forceinline__ void phase_norm(const Params& p, const Ctx& c, int i) {
    const float* MOD = (const float*)(p.ws + WS_MOD); const float* Y = (const float*)(p.ws + WS_Y); bf16* H = (bf16*)(p.ws + WS_H);
    for (int row = c.gw; row < MROWS + NS; row += c.NGW) {
        const bool smp = row >= MROWS; const int b = smp ? row - MROWS : row >> 11, mr = smp ? 4 + b : b;
        float* xo = smp ? p.out + O_YS + (size_t)b * D : p.out + O_YP + (size_t)row * D;
        const float* xi = (i <= 1) ? (smp ? p.in[1] + (size_t)b * D : p.in[0] + (size_t)row * D) : xo;
        f32x4 v[8];
#pragma unroll
        for (int j = 0; j < 8; ++j) v[j] = ((const f32x4*)xi)[c.lane + 64 * j];
        if (i > 0) {
            f32x4 y[8]; float ss = 0.f;
#pragma unroll
            for (int j = 0; j < 8; ++j) { y[j] = ((const f32x4*)(Y + (size_t)row * D))[c.lane + 64 * j]; ss += (y[j].x * y[j].x + y[j].y * y[j].y) + (y[j].z * y[j].z + y[j].w * y[j].w); }
            const float rstd = 1.0f / sqrtf(wave_sum(ss) * (1.0f / D) + RMS_EPS);
            const f32x4* gate = (const f32x4*)(MOD + (size_t)((i - 1) * 12 + mr) * 6144 + 4096); const f32x4* npo = (const f32x4*)(p.in[9] + (size_t)(i - 1) * D);
#pragma unroll
            for (int j = 0; j < 8; ++j) { const f32x4 g4 = gate[c.lane + 64 * j], n4 = npo[c.lane + 64 * j]; v[j] = v[j] + g4 * (y[j] * rstd * n4); ((f32x4*)xo)[c.lane + 64 * j] = v[j]; }
        }
        if (i < 4) {
            float ss = 0.f;
#pragma unroll
            for (int j = 0; j < 8; ++j) ss += (v[j].x * v[j].x + v[j].y * v[j].y) + (v[j].z * v[j].z + v[j].w * v[j].w);
            const float rstd = 1.0f / sqrtf(wave_sum(ss) * (1.0f / D) + RMS_EPS);
            const f32x4* sh = (const f32x4*)(MOD + (size_t)(i * 12 + mr) * 6144); const f32x4* sc = sh + 512; const f32x4* npr = (const f32x4*)(p.in[8] + (size_t)i * D);
            u32x2* ho = (u32x2*)(H + (size_t)row * D);
#pragma unroll
            for (int j = 0; j < 8; ++j) { const f32x4 s4 = sc[c.lane + 64 * j], h4 = sh[c.lane + 64 * j], n4 = npr[c.lane + 64 * j]; const f32x4 h = v[j] * rstd * n4 * (1.0f + s4) + h4;
                u32x2 w; w.x = pk2(h.x, h.y); w.y = pk2(h.z, h.w); ho[c.lane + 64 * j] = w; }
        }
    }
}

__device__ __forceinline__ void phase_window(const Params& p, const Ctx& c, int li) {
    const bf16* proj = (const bf16*)(p.ws + WS_PROJ); bf16* R = (bf16*)(p.ws + WS_R);
    for (int task = c.vcu * NTH + c.tid; task < MROWS * 512; task += c.G * NTH) {
        const int row = task >> 9, col = (task & 511) * 8, w = 2 << (col >> 10), t = row & (SEQ - 1), n = (t + 1) < w ? (t + 1) : w;
        const bf16* up = proj + (size_t)row * PIN + col;
        const u32x4 u0 = *(const u32x4*)up;
        float a[8] = {bflo(u0.x), bfhi(u0.x), bflo(u0.y), bfhi(u0.y), bflo(u0.z), bfhi(u0.z), bflo(u0.w), bfhi(u0.w)};
        float s[8];
#pragma unroll
        for (int e = 0; e < 8; ++e) s[e] = a[e];
        for (int k = 1; k < n; ++k) { const u32x4 x = *(const u32x4*)(up - (size_t)k * PIN);
            s[0] += bflo(x.x); s[1] += bfhi(x.x); s[2] += bflo(x.y); s[3] += bfhi(x.y); s[4] += bflo(x.z); s[5] += bfhi(x.z); s[6] += bflo(x.w); s[7] += bfhi(x.w); }
        const float inv = 1.0f / (float)n;
        u32x4 o; o.x = pk2(s[0] * inv - a[0], s[1] * inv - a[1]); o.y = pk2(s[2] * inv - a[2], s[3] * inv - a[3]); o.z = pk2(s[4] * inv - a[4], s[5] * inv - a[5]); o.w = pk2(s[6] * inv - a[6], s[7] * inv - a[7]);
        *(u32x4*)(R + (size_t)row * PW + col) = o;
    }
    const float* PS = (const float*)(p.ws + WS_PS); bf16* RS = (bf16*)(p.ws + WS_RS);
    for (int task = c.vcu * NTH + c.tid; task < NS * PW; task += c.G * NTH) {
        const int s = task >> 12, col = task & (PW - 1), w = 2 << (col >> 10);
        const float* st = p.in[7] + ((size_t)(li * NS + s) * 15) * PW + col; float* po = p.out + O_POOLS + ((size_t)(li * NS + s) * 15) * PW + col;
        const float un = PS[(size_t)s * PIN + col]; float sum = un;
        for (int j = 16 - w; j < 15; ++j) sum += st[(size_t)j * PW];
        for (int j = 0; j < 14; ++j) po[(size_t)j * PW] = st[(size_t)(j + 1) * PW];
        po[(size_t)14 * PW] = un;
        RS[(size_t)s * PW + col] = (bf16)f2bf(sum / (float)w - un);
    }
}

__device__ __forceinline__ void phase_attention_naive(const Params& p, const Ctx& c, int li) {
    const bf16* proj = (const bf16*)(p.ws + WS_PROJ); const float* BIAS = (const float*)(p.ws + WS_BIAS); bf16* A2 = (bf16*)(p.ws + WS_A3);
    LAS float* qs = (LAS float*)(c.lds + c.wave * 2048); LAS float* ps = qs + 128;
    for (int task = c.gw; task < MROWS * 16; task += c.NGW) {
        const int row = task >> 4, h = task & 15, t = row & (SEQ - 1);
        float og0[3], og1[3], lse[3];
#pragma unroll
        for (int g = 0; g < 3; ++g) {
            const int dil = 1 << (2 * g), nk = (t / dil) < 128 ? (t / dil) : 128;
            { const unsigned qw = *(const unsigned*)(proj + (size_t)row * AIN + g * 2048 + h * 128 + 2 * c.lane); qs[2 * c.lane] = bflo(qw); qs[2 * c.lane + 1] = bfhi(qw); }
            asm volatile("s_waitcnt lgkmcnt(0)" ::: "memory");
            float s[3], pj[3];
#pragma unroll
            for (int jj = 0; jj < 3; ++jj) {
                const int j = c.lane + 64 * jj; const bool valid = (jj < 2 || c.lane == 0) && j <= nk; float sc = NEG_INF;
                if (valid) { const bf16* kp = proj + (size_t)(row - j * dil) * AIN + QKVW + g * 2048 + h * 128; float dot = 0.f;
#pragma unroll
                    for (int ch = 0; ch < 16; ++ch) { const u32x4 kv = *(const u32x4*)(kp + 8 * ch); const f32x4 q0 = *(const LAS f32x4*)(qs + 8 * ch), q1 = *(const LAS f32x4*)(qs + 8 * ch + 4);
                        dot += (bflo(kv.x) * q0.x + bfhi(kv.x) * q0.y) + (bflo(kv.y) * q0.z + bfhi(kv.y) * q0.w) + (bflo(kv.z) * q1.x + bfhi(kv.z) * q1.y) + (bflo(kv.w) * q1.z + bfhi(kv.w) * q1.w); }
                    sc = dot * ATT_SCALE + BIAS[(g * 16 + h) * 132 + j]; }
                s[jj] = sc;
            }
            const float m = wave_max(fmaxf(fmaxf(s[0], s[1]), s[2]));
            float lsum = 0.f;
#pragma unroll
            for (int jj = 0; jj < 3; ++jj) { const int j = c.lane + 64 * jj; const bool valid = (jj < 2 || c.lane == 0) && j <= nk; pj[jj] = valid ? __expf(s[jj] - m) : 0.f; lsum += pj[jj]; if (jj < 2 || c.lane == 0) ps[j] = pj[jj]; }
            const float l = wave_sum(lsum);
            asm volatile("s_waitcnt lgkmcnt(0)" ::: "memory");
            float o0 = 0.f, o1 = 0.f;
            for (int j = 0; j <= nk; ++j) { const float pv = ps[j]; const unsigned vw = *(const unsigned*)(proj + (size_t)(row - j * dil) * AIN + 2 * QKVW + g * 2048 + h * 128 + 2 * c.lane); o0 += pv * bflo(vw); o1 += pv * bfhi(vw); }
            og0[g] = o0 / l; og1[g] = o1 / l; lse[g] = m + __logf(l);
            asm volatile("s_waitcnt lgkmcnt(0)" ::: "memory");
        }
        const float mm = fmaxf(fmaxf(lse[0], lse[1]), lse[2]); const float w0 = __expf(lse[0] - mm), w1 = __expf(lse[1] - mm), w2 = __expf(lse[2] - mm), wi = 1.0f / (w0 + w1 + w2);
        const unsigned zw = *(const unsigned*)(proj + (size_t)row * AIN + 3 * QKVW + h * 128 + 2 * c.lane);
        const float r0 = (w0 * og0[0] + w1 * og0[1] + w2 * og0[2]) * wi * silu_f(bflo(zw)), r1 = (w0 * og1[0] + w1 * og1[1] + w2 * og1[2]) * wi * silu_f(bfhi(zw));
        *(unsigned*)(A2 + (size_t)row * D + h * 128 + 2 * c.lane) = pk2(r0, r1);
    }
}
__device__ __forceinline__ void phase_attention_sample(const Params& p, const Ctx& c, int li) {
    const float* PS = (const float*)(p.ws + WS_PS); const float* BIAS = (const float*)(p.ws + WS_BIAS); bf16* A2S = (bf16*)(p.ws + WS_A3S);
    LAS float* qs = (LAS float*)(c.lds + c.wave * 2048); LAS float* ps = qs + 128;
    for (int task = c.gw; task < NS * 16; task += c.NGW) {
        const int b = task >> 4, h = task & 15;
        float og0[3], og1[3], lse[3];
#pragma unroll
        for (int g = 0; g < 3; ++g) {
            const int dil = 1 << (2 * g), L = 128 << (2 * g);
            const float* cache = p.in[4 + g] + ((size_t)(li * NS + b) * L) * 4096 + h * 128;
            const float* qp = PS + (size_t)b * AIN + g * 2048 + h * 128;
            qs[2 * c.lane] = qp[2 * c.lane]; qs[2 * c.lane + 1] = qp[2 * c.lane + 1];
            asm volatile("s_waitcnt lgkmcnt(0)" ::: "memory");
            float s[3], pj[3];
#pragma unroll
            for (int jj = 0; jj < 3; ++jj) {
                const int j = c.lane + 64 * jj; const bool valid = (jj < 2 || c.lane == 0); float sc = NEG_INF;
                if (valid) { const float* kp = j == 0 ? PS + (size_t)b * AIN + QKVW + g * 2048 + h * 128 : cache + (size_t)(L - j * dil) * 4096; float dot = 0.f;
#pragma unroll 8
                    for (int ch = 0; ch < 32; ++ch) { const f32x4 kv = *(const f32x4*)(kp + 4 * ch); const f32x4 q0 = *(const LAS f32x4*)(qs + 4 * ch); dot += (kv.x * q0.x + kv.y * q0.y) + (kv.z * q0.z + kv.w * q0.w); }
                    sc = dot * ATT_SCALE + BIAS[(g * 16 + h) * 132 + j]; }
                s[jj] = sc;
            }
            const float m = wave_max(fmaxf(fmaxf(s[0], s[1]), s[2]));
            float lsum = 0.f;
#pragma unroll
            for (int jj = 0; jj < 3; ++jj) { const int j = c.lane + 64 * jj; const bool valid = (jj < 2 || c.lane == 0); pj[jj] = valid ? __expf(s[jj] - m) : 0.f; lsum += pj[jj]; if (valid) ps[j] = pj[jj]; }
            const float l = wave_sum(lsum);
            asm volatile("s_waitcnt lgkmcnt(0)" ::: "memory");
            float o0 = 0.f, o1 = 0.f;
            for (int j = 0; j <= 128; ++j) { const float pv = ps[j]; const float* vp = j == 0 ? PS + (size_t)b * AIN + 2 * QKVW + g * 2048 + h * 128 : cache + (size_t)(L - j * dil) * 4096 + 2048;
                const f32x2 vv = *(const f32x2*)(vp + 2 * c.lane); o0 += pv * vv.x; o1 += pv * vv.y; }
            og0[g] = o0 / l; og1[g] = o1 / l; lse[g] = m + __logf(l);
            asm volatile("s_waitcnt lgkmcnt(0)" ::: "memory");
        }
        const float mm = fmaxf(fmaxf(lse[0], lse[1]), lse[2]); const float w0 = __expf(lse[0] - mm), w1 = __expf(lse[1] - mm), w2 = __expf(lse[2] - mm), wi = 1.0f / (w0 + w1 + w2);
        const f32x2 z = *(const f32x2*)(PS + (size_t)b * AIN + 3 * QKVW + h * 128 + 2 * c.lane);
        const float r0 = (w0 * og0[0] + w1 * og0[1] + w2 * og0[2]) * wi * silu_f(z.x), r1 = (w0 * og1[0] + w1 * og1[1] + w2 * og1[2]) * wi * silu_f(z.y);
        *(unsigned*)(A2S + (size_t)b * D + h * 128 + 2 * c.lane) = pk2(r0, r1);
    }
}

typedef float f32x16 __attribute__((ext_vector_type(16)));
typedef short v4i16_t __attribute__((ext_vector_type(4)));
constexpr int ATT_TAB_OFF = RING_BYTES + 1024;
__device__ __forceinline__ unsigned att_off(unsigned row, unsigned ch) { return 256u * row + 16u * (ch ^ (((row & 3u) << 2) | ((row >> 2) & 3u))); }
__device__ __forceinline__ unsigned cvt_pk_bf16(float lo, float hi) { unsigned r; asm volatile("v_cvt_pk_bf16_f32 %0, %1, %2" : "=v"(r) : "v"(lo), "v"(hi)); return r; }
__device__ __forceinline__ void att_stage(const Ctx& c, const bf16* src_base  , int b, int dil, int res, int i0) {
    const int rin = c.lane >> 4, slot = c.lane & 15;
    const bf16* src0 = src_base + (size_t)(b * SEQ + res) * AIN;
#pragma unroll
    for (int i = 0; i < 16; ++i) {
        const int k = ((64 * c.wave) & 255) + 4 * i + rin;
        int sub = i0 - 128 + k; sub = sub < 0 ? 0 : sub;
        const int ch = slot ^ ((rin << 2) | (i & 3));
        __builtin_amdgcn_global_load_lds((const unsigned*)(src0 + (size_t)(sub * dil) * AIN + ch * 8), (LAS unsigned*)(c.lds + (64 * c.wave + 4 * i) * 256), 16, 0, 0);
    }
}
__device__ __forceinline__ void phase_attention(const Params& p, const Ctx& c, int li) {
    const bf16* proj = (const bf16*)(p.ws + WS_PROJ); const float* BIAS = (const float*)(p.ws + WS_BIAS);
    bf16* OG = (bf16*)(p.ws + WS_OG); float* LSE = (float*)(p.ws + WS_LSE);
    LAS float* tab = (LAS float*)(c.lds + ATT_TAB_OFF);
    const int w = c.wave, seg = w >> 2, a = w & 3, lane = c.lane, q = lane & 31, hh = lane >> 5;
    unsigned kb[8], vb[4][2];
    { const unsigned krow = (unsigned)(seg * 256 + 32 * a + q);
#pragma unroll
      for (int s = 0; s < 8; ++s) kb[s] = att_off(krow, 2 * s + hh);
      const unsigned qq = (lane & 15) >> 2, pp = lane & 3, blk = (lane >> 4) & 1, vrow = (unsigned)(seg * 256 + 32 * a) + 4 * hh + qq;
#pragma unroll
      for (int dt = 0; dt < 4; ++dt)
#pragma unroll
          for (int t = 0; t < 2; ++t) vb[dt][t] = att_off(vrow + 8 * t, 4 * dt + 2 * blk + (pp >> 1)) + 8 * (pp & 1); }
    const LAS float* tl = tab + (32 + 4 * hh - q);
    for (int unit = c.vcu; unit < 1536; unit += c.G) {
        const int u = unit & 7, h = (unit >> 3) & 15, g = (unit >> 7) % 3, b = unit / 384, dil = 1 << (2 * g);
        int res, i0;
        if (g == 0) { res = 0; i0 = 256 * u + 128 * seg; }
        else if (g == 1) { res = u >> 1; i0 = 256 * (u & 1) + 128 * seg; }
        else { res = 2 * u + seg; i0 = 0; }
        const int kt_lo = (i0 == 0) ? 4 - a : 0;
        __syncthreads();
        att_stage(c, proj + QKVW + g * 2048 + h * 128, b, dil, res, i0);
        if (c.tid < 192) { const int x = c.tid; tab[x] = (x >= 32 && x <= 160) ? BIAS[(g * 16 + h) * 132 + (160 - x)] : NEG_INF; }
        const size_t qrow = (size_t)b * SEQ + (size_t)(i0 + 32 * a + q) * dil + res;
        bf16x8 qf[8];
#pragma unroll
        for (int s = 0; s < 8; ++s) qf[s] = *(const bf16x8*)(proj + qrow * AIN + g * 2048 + h * 128 + 16 * s + 8 * hh);
        asm volatile("s_waitcnt vmcnt(0) lgkmcnt(0)" ::: "memory");
        __syncthreads();
        f32x16 S[5];
        float mx = NEG_INF;
#pragma unroll
        for (int kt = 0; kt < 5; ++kt) {
            if (kt >= kt_lo) {
                f32x16 acc;
#pragma unroll
                for (int e = 0; e < 16; ++e) acc[e] = 0.f;
#pragma unroll
                for (int s = 0; s < 8; ++s) { const bf16x8 kf = *(const LAS bf16x8*)(c.lds + kb[s] + 8192 * kt); acc = __builtin_amdgcn_mfma_f32_32x32x16_bf16(kf, qf[s], acc, 0, 0, 0); }
#pragma unroll
                for (int e = 0; e < 16; ++e) { acc[e] = acc[e] * ATT_SCALE + tl[32 * kt + 8 * (e >> 2) + (e & 3)]; mx = fmaxf(mx, acc[e]); }
                S[kt] = acc;
            } else {
#pragma unroll
                for (int e = 0; e < 16; ++e) S[kt][e] = NEG_INF;
            }
            __builtin_amdgcn_sched_barrier(0);
        }
        mx = fmaxf(mx, __shfl_xor(mx, 32));
        float lsum = 0.f; bf16x8 pf[5][2];
#pragma unroll
        for (int kt = 0; kt < 5; ++kt) {
            float pe[16];
#pragma unroll
            for (int e = 0; e < 16; ++e) { pe[e] = __expf(S[kt][e] - mx); lsum += pe[e]; }
#pragma unroll
            for (int s2 = 0; s2 < 2; ++s2) { u32x4 pk; pk.x = cvt_pk_bf16(pe[8 * s2 + 0], pe[8 * s2 + 1]); pk.y = cvt_pk_bf16(pe[8 * s2 + 2], pe[8 * s2 + 3]); pk.z = cvt_pk_bf16(pe[8 * s2 + 4], pe[8 * s2 + 5]); pk.w = cvt_pk_bf16(pe[8 * s2 + 6], pe[8 * s2 + 7]);
                pf[kt][s2] = __builtin_bit_cast(bf16x8, pk); }
            __builtin_amdgcn_sched_barrier(0);
        }
        lsum += __shfl_xor(lsum, 32);
        __syncthreads();
        att_stage(c, proj + 2 * QKVW + g * 2048 + h * 128, b, dil, res, i0);
        asm volatile("s_waitcnt vmcnt(0)" ::: "memory");
        __syncthreads();
        const float inv = 1.0f / lsum;
        bf16* orow = OG + (size_t)g * MROWS * D + qrow * D + h * 128 + 4 * hh;
#pragma unroll
        for (int dt = 0; dt < 4; ++dt) {
            f32x16 O;
#pragma unroll
            for (int e = 0; e < 16; ++e) O[e] = 0.f;
#pragma unroll
            for (int kt = 0; kt < 5; ++kt) {
                if (kt >= kt_lo) {
#pragma unroll
                    for (int s2 = 0; s2 < 2; ++s2) {
                        const v4i16_t v0 = __builtin_amdgcn_ds_read_tr16_b64_v4i16((LAS v4i16_t*)(c.lds + vb[dt][0] + 256 * (32 * kt + 16 * s2)));
                        const v4i16_t v1 = __builtin_amdgcn_ds_read_tr16_b64_v4i16((LAS v4i16_t*)(c.lds + vb[dt][1] + 256 * (32 * kt + 16 * s2)));
                        const bf16x8 vf = {v0[0], v0[1], v0[2], v0[3], v1[0], v1[1], v1[2], v1[3]};
                        O = __builtin_amdgcn_mfma_f32_32x32x16_bf16(vf, pf[kt][s2], O, 0, 0, 0);
                    }
                }
            }
#pragma unroll
            for (int i4 = 0; i4 < 4; ++i4) { u32x2 o; o.x = cvt_pk_bf16(O[4 * i4 + 0] * inv, O[4 * i4 + 1] * inv); o.y = cvt_pk_bf16(O[4 * i4 + 2] * inv, O[4 * i4 + 3] * inv);
                *(u32x2*)(orow + 32 * dt + 8 * i4) = o; }
            __builtin_amdgcn_sched_barrier(0);
        }
        if (hh == 0) LSE[((size_t)g * MROWS + qrow) * 16 + h] = mx + __logf(lsum);
    }
    __syncthreads();
}
__device__ __forceinline__ void phase_combine(const Params& p, const Ctx& c) {
    const bf16* proj = (const bf16*)(p.ws + WS_PROJ); const bf16* OG = (const bf16*)(p.ws + WS_OG); const float* LSE = (const float*)(p.ws + WS_LSE); bf16* A2 = (bf16*)(p.ws + WS_A3);
    for (int task = c.vcu * NTH + c.tid; task < MROWS * 256; task += c.G * NTH) {
        const int row = task >> 8, ch = task & 255, h = ch >> 4;
        const float l0 = LSE[(size_t)row * 16 + h], l1 = LSE[((size_t)MROWS + row) * 16 + h], l2 = LSE[((size_t)2 * MROWS + row) * 16 + h];
        const float mm = fmaxf(fmaxf(l0, l1), l2); float w0 = __expf(l0 - mm), w1 = __expf(l1 - mm), w2 = __expf(l2 - mm); const float wi = 1.0f / (w0 + w1 + w2); w0 *= wi; w1 *= wi; w2 *= wi;
        const u32x4 o0 = *(const u32x4*)(OG + (size_t)row * D + ch * 8), o1 = *(const u32x4*)(OG + ((size_t)MROWS + row) * D + ch * 8), o2 = *(const u32x4*)(OG + ((size_t)2 * MROWS + row) * D + ch * 8);
        const u32x4 z = *(const u32x4*)(proj + (size_t)row * AIN + 3 * QKVW + ch * 8);
        u32x4 r;
        r.x = pk2((w0 * bflo(o0.x) + w1 * bflo(o1.x) + w2 * bflo(o2.x)) * silu_f(bflo(z.x)), (w0 * bfhi(o0.x) + w1 * bfhi(o1.x) + w2 * bfhi(o2.x)) * silu_f(bfhi(z.x)));
        r.y = pk2((w0 * bflo(o0.y) + w1 * bflo(o1.y) + w2 * bflo(o2.y)) * silu_f(bflo(z.y)), (w0 * bfhi(o0.y) + w1 * bfhi(o1.y) + w2 * bfhi(o2.y)) * silu_f(bfhi(z.y)));
        r.z = pk2((w0 * bflo(o0.z) + w1 * bflo(o1.z) + w2 * bflo(o2.z)) * silu_f(bflo(z.z)), (w0 * bfhi(o0.z) + w1 * bfhi(o1.z) + w2 * bfhi(o2.z)) * silu_f(bfhi(z.z)));
        r.w = pk2((w0 * bflo(o0.w) + w1 * bflo(o1.w) + w2 * bflo(o2.w)) * silu_f(bflo(z.w)), (w0 * bfhi(o0.w) + w1 * bfhi(o1.w) + w2 * bfhi(o2.w)) * silu_f(bfhi(z.w)));
        *(u32x4*)(A2 + (size_t)row * D + ch * 8) = r;
    }
}

__global__ void __launch_bounds__(NTH, 2) mega_fwd(Params p) {
    extern __shared__ __attribute__((aligned(16))) unsigned char lds_raw[];
    Ctx c;
    c.lds = (LAS unsigned char*)lds_raw;
    c.tid = threadIdx.x; c.lane = c.tid & 63; c.wave = __builtin_amdgcn_readfirstlane(c.tid >> 6);
    c.G = gridDim.x; { const int bx = blockIdx.x; c.vcu = (c.G % 8 == 0) ? (bx % 8) * (c.G / 8) + bx / 8 : bx; }
    c.gw = c.vcu * NWAVES + c.wave; c.NGW = c.G * NWAVES;
    volatile LAS unsigned* MISC = (volatile LAS unsigned*)(c.lds + MISC_OFF);
    for (int u = c.tid; u < (LDS_BYTES - LDSCTL_OFF) / 4; u += NTH) ((LAS unsigned*)(c.lds + LDSCTL_OFF))[u] = 0u;
    __syncthreads();
    unsigned* ctl = (unsigned*)(p.ws + WS_CTL);
    XcdBarrier bar; bar.bar = ctl + CW_BAR; bar.x = 0; bar.st = nullptr;
    const int lo = p.ph_lo, hi = p.ph_hi;
    if (hi - lo > 1) bar = xcd_barrier_post(ctl + CW_BAR, MISC + 8);
#define IN(k) (lo <= (k) && (k) < hi)
#define SEAM(k) do { if (IN(k) && IN((k) + 1)) xcd_barrier(bar); } while (0)
    bf16* const H = (bf16*)(p.ws + WS_H); bf16* const PROJ = (bf16*)(p.ws + WS_PROJ); bf16* const R = (bf16*)(p.ws + WS_R); bf16* const A3 = (bf16*)(p.ws + WS_A3);
    float* const Y = (float*)(p.ws + WS_Y); float* const PS = (float*)(p.ws + WS_PS); bf16* const RS = (bf16*)(p.ws + WS_RS); bf16* const A3S = (bf16*)(p.ws + WS_A3S);

    if (IN(0)) phase_prologue(p, c);
    SEAM(0);
    const Ctx c0 = c;
    for (int i = 0; i < 4; ++i) {
        const int ph = 1 + 5 * i, li = i >> 1;
        Ctx c = c0; asm volatile("" : "+v"(c.tid), "+v"(c.lane));
        if (IN(ph)) phase_norm(p, c, i);
        SEAM(ph);
        if (!(i & 1)) {
            const bf16* Wpi = (const bf16*)(p.ws + WS_WPI) + (size_t)li * PIN * D; const bf16* Wpg = (const bf16*)(p.ws + WS_WPG) + (size_t)li * PW * 1024; const bf16* Wpo = (const bf16*)(p.ws + WS_WPO) + (size_t)li * D * PW;
            if (IN(ph + 1)) {
                sgemm8(c, H + (size_t)MROWS * D, D, 0, Wpi, PIN, D, [&](int s, int n, float v) { PS[(size_t)s * PIN + n] = v; });
                run_gemm<0>(c, pg8::Gemm{H, Wpi, MROWS, PIN, D, D, 0}, StG1p{PROJ, p.out + O_POOLP + (size_t)li * 4 * 15 * PW});
            }
            SEAM(ph + 1);
            if (IN(ph + 2)) phase_window(p, c, li);
            SEAM(ph + 2);
            if (IN(ph + 3)) {
                const float* scale = p.in[15] + (size_t)li * PW;
                sgemm8(c, RS, PW, 1024, Wpg, PW, 1024, [&](int s, int n, float v) { A3S[(size_t)s * PW + n] = (bf16)f2bf(v * scale[n] * silu_f(PS[(size_t)s * PIN + PW + n])); });
                run_gemm<1>(c, pg8::Gemm{R, Wpg, MROWS, PW, 1024, PW, 4}, StG2p{PROJ, scale, A3});
            }
            SEAM(ph + 3);
            if (IN(ph + 4)) {
                sgemm8(c, A3S, PW, 0, Wpo, D, PW, [&](int s, int n, float v) { Y[(size_t)(MROWS + s) * D + n] = v; });
                run_gemm<2>(c, pg8::Gemm{A3, Wpo, MROWS, D, PW, PW, 0}, StF32{Y, D});
            }
            SEAM(ph + 4);
        } else {
            const bf16* Wai = (const bf16*)(p.ws + WS_WAI) + (size_t)li * AIN * D; const bf16* Wao = (const bf16*)(p.ws + WS_WAO) + (size_t)li * D * D;
            if (IN(ph + 1)) {
                float* const out = p.out;
                sgemm8(c, H + (size_t)MROWS * D, D, 0, Wai, AIN, D, [&](int s, int n, float v) {
                    PS[(size_t)s * AIN + n] = v;
                    if (n >= QKVW && n < 3 * QKVW) { int cc = n - QKVW; const int kv = cc >= QKVW ? 1 : 0; cc -= kv * QKVW; const int g = cc >> 11, he = cc & 2047;
                        const size_t base = g == 0 ? O_KV0S : (g == 1 ? O_KV1S : O_KV2S); out[base + (size_t)(li * NS + s) * 4096 + kv * 2048 + he] = v; } });
                run_gemm<3>(c, pg8::Gemm{H, Wai, MROWS, AIN, D, D, 0}, StG1a{PROJ, p.out, li});
            }
            SEAM(ph + 1);
#if MK_NAIVE_ATT
            if (IN(ph + 2)) { phase_attention_naive(p, c, li); phase_attention_sample(p, c, li); }
            SEAM(ph + 2);
#else
            if (IN(ph + 2)) { phase_attention_sample(p, c, li); phase_attention(p, c, li); }
            SEAM(ph + 2);
            if (IN(ph + 3)) phase_combine(p, c);
            SEAM(ph + 3);
#endif
            if (IN(ph + 4)) {
                sgemm8(c, A3S, D, 0, Wao, D, D, [&](int s, int n, float v) { Y[(size_t)(MROWS + s) * D + n] = v; });
                run_gemm<4>(c, pg8::Gemm{A3, Wao, MROWS, D, D, D, 0}, StF32{Y, D});
            }
            SEAM(ph + 4);
        }
    }
    if (IN(21)) phase_norm(p, c, 4);
#undef IN
#undef SEAM
}

extern "C" void kernel_launch(void* const* d_in, const int* in_sizes, int n_in, void* d_out, int out_size, void* d_ws, size_t ws_size, hipStream_t stream) {
    static int grid = 0;
    if (grid == 0) {
        if (n_in != 19 || (size_t)out_size != O_END || ws_size < WS_END) { fprintf(stderr, "kernel_launch: unexpected shapes: n_in %d out %d ws %zu; nothing launched\n", n_in, out_size, ws_size); grid = -1; return; }
        int dev = 0, cus = 0, per_cu = 0;
        if (hipGetDevice(&dev) != hipSuccess || hipDeviceGetAttribute(&cus, hipDeviceAttributeMultiprocessorCount, dev) != hipSuccess) { fprintf(stderr, "kernel_launch: device query failed\n"); grid = -1; return; }
        if (hipFuncSetAttribute((const void*)mega_fwd, hipFuncAttributeMaxDynamicSharedMemorySize, LDS_BYTES) != hipSuccess) { fprintf(stderr, "kernel_launch: hipFuncSetAttribute failed\n"); grid = -1; return; }
        if (hipOccupancyMaxActiveBlocksPerMultiprocessor(&per_cu, (const void*)mega_fwd, NTH, LDS_BYTES) != hipSuccess || per_cu < 1) fprintf(stderr, "kernel_launch: occupancy query reports %d workgroups per CU\n", per_cu);
        (void)hipGetLastError();
        grid = cus;
    }
    if (grid < 0) return;
    if (hipMemsetAsync((char*)d_ws + WS_CTL, 0, CTL_ZERO_BYTES, stream) != hipSuccess) { fprintf(stderr, "kernel_launch: memset failed\n"); return; }
    Params p{};
    for (int i = 0; i < 19; ++i) p.in[i] = (const float*)d_in[i];
    p.out = (float*)d_out; p.ws = (unsigned char*)d_ws;
#if MK_ONE_LAUNCH
    p.ph_lo = 0; p.ph_hi = N_PHASES;
    hipLaunchKernelGGL(mega_fwd, dim3(grid), dim3(NTH), LDS_BYTES, stream, p);
#else
    for (int ph = 0; ph < N_PHASES; ++ph) {
        if (MK_NAIVE_ATT && ph >= 1 && ph < 21 && ((ph - 1) % 5) == 3 && (((ph - 1) / 5) & 1)) continue;
        p.ph_lo = ph; p.ph_hi = ph + 1;
        hipLaunchKernelGGL(mega_fwd, dim3(grid), dim3(NTH), LDS_BYTES, stream, p);
    }
#endif
    const hipError_t le = hipPeekAtLastError();
    if (le != hipSuccess) fprintf(stderr, "kernel_launch: launch failed: %s\n", hipGetErrorName(le));
}
```

```cpp
#include <hip/hip_runtime.h>
#include <cstdio>
#include <cstdint>
#define GAS __attribute__((address_space(1)))
#define LAS __attribute__((address_space(3)))
namespace pg8 {
#define PG8_LAS __attribute__((address_space(3)))
typedef unsigned short bf16_t;
typedef short bf16x8 __attribute__((ext_vector_type(8)));
typedef float f32x4 __attribute__((ext_vector_type(4)));
typedef unsigned u32x4 __attribute__((ext_vector_type(4)));
constexpr int BM = 256, BK = 64, HALF = 128, HTB = HALF * BK * 2  , STAGE_BYTES = 8 * HTB, NXCD = 8, WGM = 8;

__host__ __device__ __forceinline__ int lds_byte(int r, int c) { const int st = (r >> 4) * 2 + (c >> 5), rr = r & 15, cc = c & 31, ob = rr * 64 + cc * 2; return st * 1024 + (ob ^ (((ob >> 9) & 1) << 5)); }
__host__ __device__ __forceinline__ void stage_rc(int b, int& R, int& C) { const int st = b / 1024, sb = b % 1024, swz = sb ^ (((sb >> 9) & 1) << 5); R = (st >> 1) * 16 + swz / 64; C = (st & 1) * 32 + (swz % 64) / 2; }
__host__ __device__ __forceinline__ int perm32(int rho) { const int n = rho >> 4, i = rho & 15; return 8 * (i >> 2) + 4 * n + (i & 3); }

struct Unit { int pm, pn; };
struct Gemm { const bf16_t* A; const bf16_t* Bt; int M, N, K, lda, agrp, ldb, bmode; };
__device__ __forceinline__ size_t gemm_boff(const Gemm& g, int pm) { return g.bmode ? ((size_t)(pm >> 4) * 2048 * 4096 + (size_t)((pm >> 2) & 3) * 1024) * 2 : (size_t)0; }

struct StaticOrder {
    int nM, nN, nwg, G, c;
    __host__ __device__ void init(int M, int N, int G_, int c_) { nM = M / BM; nN = N / BM; nwg = nM * nN; G = G_; c = c_; }
    __host__ __device__ bool next(int i, Unit& u) const {
        const long L = (long)i * G + c; if (L >= nwg) return false;
        int wgid = (int)L; { const int q = nwg / NXCD, r = nwg % NXCD, xcd = wgid % NXCD, off = wgid / NXCD; wgid = (xcd < r ? xcd * (q + 1) : r * (q + 1) + (xcd - r) * q) + off; }
        const int nig = WGM * nN, gid = wgid / nig, fm = gid * WGM, gsz = (nM - fm) < WGM ? (nM - fm) : WGM;
        u.pm = fm + ((wgid % nig) % gsz); u.pn = (wgid % nig) / gsz; return true;
    }
    __device__ __forceinline__ void a_ready(const Unit&) const {}
    __device__ __forceinline__ void done(const Unit&) const {}
};

template <class Epi, class Sched, bool ALIGN_EPI = false, bool SP2 = false>
__device__ __forceinline__ void gemm_phase(PG8_LAS unsigned char* lds, const Gemm g, const Sched& S, const Epi& E) {
    int tid = threadIdx.x; asm volatile("" : "+v"(tid));
    const int wid = __builtin_amdgcn_readfirstlane(tid >> 6), lane = tid & 63, wr = wid >> 2, wc = wid & 3, fr = lane & 15, fq = lane >> 4;
    const int K = g.K, nt = K / BK;
    unsigned voffA[2], voffB[2];
#pragma unroll
    for (int i = 0; i < 2; ++i) { int R, C; stage_rc(tid * 16 + i * 8192, R, C); const int Rb = Epi::PERM ? ((R & ~31) + perm32(R & 31)) : R;
        voffA[i] = (unsigned)(R * g.lda + C) * 2u; voffB[i] = (unsigned)(Rb * g.ldb + C) * 2u; }
    const size_t kstep = (size_t)(BK * 2);
    const size_t hstepB = (size_t)HALF * g.ldb * 2, hstepA = (size_t)HALF * g.lda * 2;
    const size_t tstepB = 2 * hstepB, tstepA = 2 * hstepA;
    const unsigned ldsw = (unsigned)wid * 1024u;
    const int aoff = lds_byte(wr * 64 + fr, fq * 8), boff = lds_byte(wc * 32 + fr, fq * 8);
#define PG8_SA(b, h) (((b) * 2 + (h)) * HTB)
#define PG8_SB(b, h) ((4 + (b) * 2 + (h)) * HTB)
#define PG8_STAGE(bufoff, gbase, voff) do { _Pragma("unroll") for (int _i = 0; _i < 2; ++_i) \
        __builtin_amdgcn_global_load_lds((const unsigned*)((const char*)(gbase) + (voff)[_i]), (PG8_LAS unsigned*)(lds + (bufoff) + ldsw + _i * 8192), 16, 0, 0); } while (0)
#define PG8_LDA(dst, b, h) do { _Pragma("unroll") for (int m = 0; m < 4; ++m) _Pragma("unroll") for (int k = 0; k < 2; ++k) dst[m][k] = *(const PG8_LAS bf16x8*)(lds + PG8_SA(b, h) + aoff + m * 2048 + k * 1024); } while (0)
#define PG8_LDB(dst, b, h) do { _Pragma("unroll") for (int n = 0; n < 2; ++n) _Pragma("unroll") for (int k = 0; k < 2; ++k) dst[n][k] = *(const PG8_LAS bf16x8*)(lds + PG8_SB(b, h) + boff + n * 2048 + k * 1024); } while (0)
#define PG8_MMA(ai, bj, At, Bt) do { __builtin_amdgcn_s_setprio(1); _Pragma("unroll") for (int m = 0; m < 4; ++m) _Pragma("unroll") for (int n = 0; n < 2; ++n) _Pragma("unroll") for (int k = 0; k < 2; ++k) \
        acc[ai][bj][m][n] = __builtin_amdgcn_mfma_f32_16x16x32_bf16(Bt[n][k], At[m][k], acc[ai][bj][m][n], 0, 0, 0); __builtin_amdgcn_s_setprio(0); } while (0)
#define PG8_WAIT_V(n) asm volatile("s_waitcnt vmcnt(" #n ")" ::: "memory")
#define PG8_WAIT_L(n) asm volatile("s_waitcnt lgkmcnt(" #n ")" ::: "memory")
#define PG8_BAR __builtin_amdgcn_s_barrier()
#define PG8_SCHED __builtin_amdgcn_sched_barrier(0)
    Unit cur, nxt; int ui = 0;
    if (!S.next(0, cur)) return;
    f32x4 acc[2][2][4][2];
#pragma unroll
    for (int a = 0; a < 2; ++a)
#pragma unroll
        for (int b = 0; b < 2; ++b)
#pragma unroll
            for (int m = 0; m < 4; ++m)
#pragma unroll
                for (int n = 0; n < 2; ++n) acc[a][b][m][n] = (f32x4){0.f, 0.f, 0.f, 0.f};
    bf16x8 At[4][2], B0[2][2], B1[2][2];
    const char* cA = (const char*)g.A + (size_t)cur.pm * tstepA + (g.agrp ? (size_t)(cur.pn / g.agrp) * K * 2 : (size_t)0); const char* cB = (const char*)g.Bt + (size_t)cur.pn * tstepB + gemm_boff(g, cur.pm);
    S.a_ready(cur);
    if constexpr (SP2) {
        PG8_STAGE(PG8_SB(0, 0), cB, voffB); PG8_STAGE(PG8_SB(0, 1), cB + hstepB, voffB); PG8_STAGE(PG8_SA(0, 0), cA, voffA); PG8_STAGE(PG8_SA(0, 1), cA + hstepA, voffA);
        if (wr == 1) PG8_BAR;
        PG8_WAIT_V(2); PG8_BAR;
        PG8_STAGE(PG8_SB(1, 0), cB + kstep, voffB); PG8_STAGE(PG8_SA(1, 0), cA + kstep, voffA); PG8_STAGE(PG8_SB(1, 1), cB + hstepB + kstep, voffB);
        PG8_WAIT_V(6); PG8_BAR;
    } else {
        PG8_STAGE(PG8_SB(0, 0), cB, voffB); PG8_STAGE(PG8_SA(0, 0), cA, voffA); PG8_STAGE(PG8_SB(0, 1), cB + hstepB, voffB); PG8_STAGE(PG8_SA(0, 1), cA + hstepA, voffA);
        if (wr == 1) PG8_BAR;
        PG8_WAIT_V(4); PG8_BAR;
        PG8_STAGE(PG8_SB(1, 0), cB + kstep, voffB); PG8_STAGE(PG8_SA(1, 0), cA + kstep, voffA); PG8_STAGE(PG8_SB(1, 1), cB + hstepB + kstep, voffB);
        PG8_WAIT_V(6); PG8_BAR;
    }
    for (;;) {
        const bool has_next = S.next(ui + 1, nxt);
        const char* nA = has_next ? (const char*)g.A + (size_t)nxt.pm * tstepA + (g.agrp ? (size_t)(nxt.pn / g.agrp) * K * 2 : (size_t)0) : cA; const char* nB = has_next ? (const char*)g.Bt + (size_t)nxt.pn * tstepB + gemm_boff(g, nxt.pm) : cB;
        for (int t = 0; t < nt; t += 2) {
            const bool last = (t == nt - 2);
            const char* a1 = cA + (size_t)(t + 1) * kstep;
            const char* a2 = last ? nA : cA + (size_t)(t + 2) * kstep; const char* b2 = last ? nB : cB + (size_t)(t + 2) * kstep;
            const char* a3 = a2 + kstep; const char* b3 = b2 + kstep;
            if (last && has_next) S.a_ready(nxt);
            if constexpr (SP2) {
            PG8_LDB(B0, 0, 0); PG8_LDB(B1, 0, 1); PG8_SCHED; PG8_LDA(At, 0, 0); PG8_STAGE(PG8_SA(1, 1), a1 + hstepA, voffA);
            PG8_WAIT_V(8); PG8_WAIT_L(0); PG8_BAR; PG8_MMA(0, 0, At, B0); PG8_MMA(0, 1, At, B1); PG8_BAR; PG8_SCHED;
            PG8_LDA(At, 0, 1); PG8_STAGE(PG8_SB(0, 0), b2, voffB); PG8_STAGE(PG8_SB(0, 1), b2 + hstepB, voffB); PG8_STAGE(PG8_SA(0, 0), a2, voffA);
            PG8_WAIT_V(8); PG8_WAIT_L(0); PG8_BAR; PG8_MMA(1, 0, At, B0); PG8_MMA(1, 1, At, B1); PG8_BAR; PG8_SCHED;
            PG8_LDB(B0, 1, 0); PG8_LDB(B1, 1, 1); PG8_SCHED; PG8_LDA(At, 1, 0); PG8_STAGE(PG8_SA(0, 1), a2 + hstepA, voffA);
            PG8_WAIT_V(8); PG8_WAIT_L(0); PG8_BAR; PG8_MMA(0, 0, At, B0); PG8_MMA(0, 1, At, B1); PG8_BAR; PG8_SCHED;
            PG8_LDA(At, 1, 1); PG8_STAGE(PG8_SB(1, 0), b3, voffB); PG8_STAGE(PG8_SB(1, 1), b3 + hstepB, voffB); PG8_STAGE(PG8_SA(1, 0), a3, voffA);
            PG8_WAIT_V(8); PG8_WAIT_L(0); PG8_BAR; PG8_MMA(1, 0, At, B0); PG8_MMA(1, 1, At, B1); PG8_BAR; PG8_SCHED;
            } else {
            PG8_LDB(B0, 0, 0); PG8_SCHED; PG8_LDA(At, 0, 0); PG8_STAGE(PG8_SA(1, 1), a1 + hstepA, voffA);
            PG8_WAIT_L(8); PG8_BAR; PG8_WAIT_L(0); PG8_MMA(0, 0, At, B0); PG8_BAR; PG8_SCHED;
            PG8_LDB(B1, 0, 1); PG8_STAGE(PG8_SB(0, 0), b2, voffB);
            PG8_BAR; PG8_WAIT_L(0); PG8_MMA(0, 1, At, B1); PG8_BAR;
            PG8_LDA(At, 0, 1); PG8_STAGE(PG8_SA(0, 0), a2, voffA);
            PG8_BAR; PG8_WAIT_L(0); PG8_MMA(1, 0, At, B0); PG8_BAR; PG8_SCHED;
            PG8_STAGE(PG8_SB(0, 1), b2 + hstepB, voffB);
            PG8_WAIT_V(6); PG8_BAR; PG8_MMA(1, 1, At, B1); PG8_BAR;
            PG8_LDB(B0, 1, 0); PG8_SCHED; PG8_LDA(At, 1, 0); PG8_STAGE(PG8_SA(0, 1), a2 + hstepA, voffA);
            PG8_WAIT_L(8); PG8_BAR; PG8_WAIT_L(0); PG8_MMA(0, 0, At, B0); PG8_BAR; PG8_SCHED;
            PG8_LDB(B1, 1, 1); PG8_STAGE(PG8_SB(1, 0), b3, voffB);
            PG8_BAR; PG8_WAIT_L(0); PG8_MMA(0, 1, At, B1); PG8_BAR;
            PG8_LDA(At, 1, 1); PG8_STAGE(PG8_SA(1, 0), a3, voffA);
            PG8_BAR; PG8_WAIT_L(0); PG8_MMA(1, 0, At, B0); PG8_BAR; PG8_SCHED;
            PG8_STAGE(PG8_SB(1, 1), b3 + hstepB, voffB);
            PG8_WAIT_V(6); PG8_BAR; PG8_MMA(1, 1, At, B1); PG8_BAR;
            }
        }
        if constexpr (ALIGN_EPI) { if (wr == 0) PG8_BAR; }
        if constexpr (!Epi::AFTER_DRAIN) { E(acc, cur, wr, wc, fr, fq); S.done(cur); }
        if (!has_next) break;
#pragma unroll
        for (int a = 0; a < 2; ++a)
#pragma unroll
            for (int b = 0; b < 2; ++b)
#pragma unroll
                for (int m = 0; m < 4; ++m)
#pragma unroll
                    for (int n = 0; n < 2; ++n) acc[a][b][m][n] = (f32x4){0.f, 0.f, 0.f, 0.f};
        cur = nxt; cA = nA; cB = nB; ++ui;
        if constexpr (ALIGN_EPI) { if (wr == 1) PG8_BAR; }
    }
    PG8_WAIT_V(0);
    if constexpr (!ALIGN_EPI) { if (wr == 0) PG8_BAR; }
    PG8_BAR;
    if constexpr (Epi::AFTER_DRAIN) { E.fused(acc, cur, wr, wc, fr, fq, lds, wid, lane); S.done(cur); }
#undef PG8_SA
#undef PG8_SB
#undef PG8_STAGE
#undef PG8_LDA
#undef PG8_LDB
#undef PG8_MMA
#undef PG8_WAIT_V
#undef PG8_WAIT_L
#undef PG8_BAR
#undef PG8_SCHED
}
}

#define XB_TMO      128
#define XB_XCNT(j)  (256  + 64 * (j))
#define XB_XSUB(j)  (1280 + 64 * (j))
#define XB_XGEN(j)  (2304 + 64 * (j))
#define XB_TOP      3328
#define XB_TOPGEN   3392
#define XCD_BAR_WORDS 3456
#define XB_SPIN_CAP (1u << 18)

__device__ __forceinline__ unsigned xb_ld(unsigned* p)              { return __hip_atomic_load(p, __ATOMIC_RELAXED, __HIP_MEMORY_SCOPE_AGENT); }
__device__ __forceinline__ unsigned xb_add(unsigned* p, unsigned v) { return __hip_atomic_fetch_add(p, v, __ATOMIC_RELAXED, __HIP_MEMORY_SCOPE_AGENT); }
__device__ __forceinline__ unsigned xb_xcc_id() { return (unsigned)__builtin_amdgcn_s_getreg((3 << 11) | 20) & 0xFu; }
#define XB_SPIN(cond, bar) do { unsigned _sp = 0; while (cond) { __builtin_amdgcn_s_sleep(1); \
    if ((++_sp & 255u) == 0u) { if (xb_ld(&(bar)[XB_TMO])) break; if (_sp > XB_SPIN_CAP) { atomicAdd(&(bar)[XB_TMO], 1u); break; } } } } while (0)

struct XcdBarrier {
    unsigned* bar; unsigned x;
    volatile LAS unsigned* st;
};

__device__ __forceinline__ XcdBarrier xcd_barrier_post(unsigned* bar, volatile LAS unsigned* st) {
    XcdBarrier b; b.bar = bar; b.x = xb_xcc_id(); b.st = st;
    if (threadIdx.x == 0) (void)xb_add(&bar[XB_XCNT(b.x)], 1u);
    return b;
}
__device__ __forceinline__ void xcd_barrier_complete(unsigned* bar, unsigned x, unsigned& nloc, unsigned& nx) {
    const unsigned G = gridDim.x * gridDim.y * gridDim.z;
    unsigned sum, cnt, mine, sp = 0u;
    for (;;) {
        sum = 0u; cnt = 0u; mine = 0u;
#pragma unroll
        for (unsigned j = 0; j < 16; ++j) { const unsigned c = xb_ld(&bar[XB_XCNT(j)]); sum += c; cnt += (c > 0u) ? 1u : 0u; mine = (j == x) ? c : mine; }
        if (sum == G) break;
        __builtin_amdgcn_s_sleep(1);
        if ((++sp & 255u) == 0u) { if (xb_ld(&bar[XB_TMO])) break; if (sp > XB_SPIN_CAP) { atomicAdd(&bar[XB_TMO], 1u); break; } }
    }
    nloc = mine > 0u ? mine : 1u; nx = cnt > 0u ? cnt : 1u;
}

__device__ __forceinline__ void xcd_barrier(const XcdBarrier& b) {
    asm volatile("s_waitcnt vmcnt(0)" ::: "memory");
    __syncthreads();
    if (threadIdx.x == 0) {
        unsigned* bar = b.bar;
        __builtin_amdgcn_s_waitcnt(0);
        unsigned nloc = b.st[0], nx = b.st[1];
        if (nloc == 0u) { xcd_barrier_complete(bar, b.x, nloc, nx); b.st[0] = nloc; b.st[1] = nx; }
        const unsigned old = xb_add(&bar[XB_XSUB(b.x)], 1u);
        const unsigned gen = old / nloc;
        if (old + 1u == (gen + 1u) * nloc) {
            __builtin_amdgcn_fence(__ATOMIC_RELEASE, "agent");
            asm volatile("s_waitcnt vmcnt(0)" ::: "memory");
            const unsigned og = xb_add(&bar[XB_TOP], 1u);
            const unsigned tg = og / nx;
            if (og + 1u == (tg + 1u) * nx) xb_add(&bar[XB_TOPGEN], 1u);
            else XB_SPIN(xb_ld(&bar[XB_TOPGEN]) == tg, bar);
            __builtin_amdgcn_fence(__ATOMIC_ACQUIRE, "agent");
            xb_add(&bar[XB_XGEN(b.x)], 1u);
            asm volatile("s_waitcnt vmcnt(0)" ::: "memory");
        } else {
            XB_SPIN(xb_ld(&bar[XB_XGEN(b.x)]) == gen, bar);
            __builtin_amdgcn_fence(__ATOMIC_ACQUIRE, "agent");
            asm volatile("s_waitcnt vmcnt(0)" ::: "memory");
        }
    }
    __syncthreads();
}

#ifndef MK_NAIVE_GEMM
#define MK_NAIVE_GEMM 0
#endif
#ifndef MK_NAIVE_ATT
#define MK_NAIVE_ATT 0
#endif
#ifndef MK_REP_KIND
#define MK_REP_KIND -1
#endif
#ifndef MK_REP_N
#define MK_REP_N 2
#endif
#define REPS(kind) for (int rep_ = 0; rep_ < ((MK_REP_KIND == (kind)) ? 1 + MK_REP_N : 1); ++rep_)
#ifndef MK_STAGGER
#define MK_STAGGER 0
#endif
#ifndef MK_DOUBLE_STORE
#define MK_DOUBLE_STORE 0
#endif
#ifndef MK_ONE_LAUNCH
#define MK_ONE_LAUNCH 1
#endif

constexpr int D = 2048, NB = 4, SEQ = 2048, MROWS = NB * SEQ, NS = 8;
constexpr int PW = 4096, PIN = 8192, QKVW = 6144, AIN = 20480;
constexpr int NWAVES = 8, NTH = 512;
constexpr float RMS_EPS = 1e-6f, ATT_SCALE = 0.08838834764831845f, NEG_INF = -1e30f;
constexpr size_t O_YP = 0, O_YS = O_YP + (size_t)MROWS * D, O_KV0P = O_YS + (size_t)NS * D, O_KV1P = O_KV0P + (size_t)2 * 4 * 128 * 4096, O_KV2P = O_KV1P + (size_t)2 * 4 * 512 * 4096,
                 O_POOLP = O_KV2P + (size_t)2 * 4 * 2048 * 4096, O_KV0S = O_POOLP + (size_t)2 * 4 * 15 * 4096, O_KV1S = O_KV0S + 2 * 8 * 4096, O_KV2S = O_KV1S + 2 * 8 * 4096,
                 O_POOLS = O_KV2S + 2 * 8 * 4096, O_END = O_POOLS + (size_t)2 * 8 * 15 * 4096;
static_assert(O_END == 106545152, "output size");
constexpr size_t MiB = 1u << 20;
constexpr size_t WS_CTL = 0, CTL_ZERO_BYTES = 1 * MiB;
constexpr size_t WS_MOD = 1 * MiB;
constexpr size_t WS_BIAS = 3 * MiB;
constexpr size_t WS_PS = 4 * MiB;
constexpr size_t WS_RS = 5 * MiB;
constexpr size_t WS_A3S = 6 * MiB;
constexpr size_t WS_OGS = 7 * MiB;
constexpr size_t WS_LSES = 7 * MiB + 896 * 1024;
constexpr size_t WS_WG1 = 8 * MiB;
constexpr size_t WS_WPG = 72 * MiB;
constexpr size_t WS_WPO = 88 * MiB;
constexpr size_t WS_WAI = 120 * MiB;
constexpr size_t WS_WAO = 280 * MiB;
constexpr size_t WS_H = 296 * MiB;
constexpr size_t WS_PROJ = 330 * MiB;
constexpr size_t WS_WUN = 650 * MiB;
constexpr size_t WS_WUT = 682 * MiB;
constexpr size_t WS_A3 = 714 * MiB;
constexpr size_t WS_Y = 778 * MiB;
constexpr size_t WS_OG = 844 * MiB;
constexpr size_t WS_LSE = 940 * MiB;
constexpr size_t WS_END = 942 * MiB;
constexpr int CW_BAR = 4096;
constexpr int RING_BYTES = 131072, LDSCTL_OFF = RING_BYTES, MISC_OFF = LDSCTL_OFF + 320, LDS_BYTES = 147456;
constexpr int N_PHASES = 23;

typedef unsigned short bf16;
typedef short bf16x8 __attribute__((ext_vector_type(8)));
typedef float f32x4 __attribute__((ext_vector_type(4)));
typedef float f32x2 __attribute__((ext_vector_type(2)));
typedef unsigned u32x4 __attribute__((ext_vector_type(4)));
typedef unsigned u32x2 __attribute__((ext_vector_type(2)));

__device__ __forceinline__ unsigned f2bf(float f) { unsigned u = __builtin_bit_cast(unsigned, f); return (u + 0x7fffu + ((u >> 16) & 1u)) >> 16; }
__device__ __forceinline__ unsigned pk2(float lo, float hi) { return f2bf(lo) | (f2bf(hi) << 16); }
__device__ __forceinline__ float bflo(unsigned w) { return __builtin_bit_cast(float, w << 16); }
__device__ __forceinline__ float bfhi(unsigned w) { return __builtin_bit_cast(float, w & 0xffff0000u); }
__device__ __forceinline__ float silu_f(float x) { return x / (1.0f + __expf(-x)); }
__device__ __forceinline__ float wave_sum(float v) {
#pragma unroll
    for (int o = 1; o < 64; o <<= 1) v += __shfl_xor(v, o);
    return v;
}
__device__ __forceinline__ float wave_max(float v) {
#pragma unroll
    for (int o = 1; o < 64; o <<= 1) v = fmaxf(v, __shfl_xor(v, o));
    return v;
}
__device__ __forceinline__ unsigned cvt_pk_bf16(float lo, float hi) { unsigned r; asm volatile("v_cvt_pk_bf16_f32 %0, %1, %2" : "=v"(r) : "v"(lo), "v"(hi)); return r; }
__device__ __forceinline__ u32x4 pack8(const f32x4 a, const f32x4 b) { u32x4 w; w.x = cvt_pk_bf16(a.x, a.y); w.y = cvt_pk_bf16(a.z, a.w); w.z = cvt_pk_bf16(b.x, b.y); w.w = cvt_pk_bf16(b.z, b.w); return w; }
__device__ __forceinline__ float dot8(const u32x4 a, const u32x4 b) {
    return (bflo(a.x) * bflo(b.x) + bfhi(a.x) * bfhi(b.x)) + (bflo(a.y) * bflo(b.y) + bfhi(a.y) * bfhi(b.y)) + (bflo(a.z) * bflo(b.z) + bfhi(a.z) * bfhi(b.z)) + (bflo(a.w) * bflo(b.w) + bfhi(a.w) * bfhi(b.w));
}

struct Params { const float* in[19]; float* out; unsigned char* ws; int ph_lo, ph_hi; };
struct Ctx { LAS unsigned char* lds; int tid, lane, wave, vcu, G, gw, NGW; };

template <class S8> struct Epi8 {
    static constexpr bool PERM = true, AFTER_DRAIN = false;
    S8 s;
    __device__ __forceinline__ void operator()(const pg8::f32x4 (&acc)[2][2][4][2], const pg8::Unit& u, int wr, int wc, int fr, int fq) const {
        const int row0 = u.pm * 256 + wr * 64 + fr, col0 = u.pn * 256 + wc * 32 + 8 * fq;
#pragma unroll
        for (int ai = 0; ai < 2; ++ai)
#pragma unroll
            for (int m = 0; m < 4; ++m)
#pragma unroll
                for (int bj = 0; bj < 2; ++bj) { s.store8(row0 + ai * 128 + m * 16, col0 + bj * 128, acc[ai][bj][m][0], acc[ai][bj][m][1]);
#if MK_DOUBLE_STORE
                    asm volatile("" ::: "memory"); s.store8(row0 + ai * 128 + m * 16, col0 + bj * 128, acc[ai][bj][m][0], acc[ai][bj][m][1]);
#endif
                }
    }
};
struct StWg1 {
    bf16* wg1;
    __device__ __forceinline__ void store8(int row, int col, const f32x4 v0, const f32x4 v1) const { *(u32x4*)(wg1 + ((size_t)(row >> 12) * PIN + (row & 4095)) * D + col) = pack8(v0, v1); }
};
struct StG2p {
    const bf16* proj; const float* scale; bf16* a3;
    __device__ __forceinline__ void store8(int row, int col, const f32x4 v0, const f32x4 v1) const {
        const u32x4 z = *(const u32x4*)(proj + (size_t)row * PIN + PW + col);
        const f32x4 s0 = *(const f32x4*)(scale + col), s1 = *(const f32x4*)(scale + col + 4);
        f32x4 a, b;
        a.x = v0.x * s0.x * silu_f(bflo(z.x)); a.y = v0.y * s0.y * silu_f(bfhi(z.x)); a.z = v0.z * s0.z * silu_f(bflo(z.y)); a.w = v0.w * s0.w * silu_f(bfhi(z.y));
        b.x = v1.x * s1.x * silu_f(bflo(z.z)); b.y = v1.y * s1.y * silu_f(bfhi(z.z)); b.z = v1.z * s1.z * silu_f(bflo(z.w)); b.w = v1.w * s1.w * silu_f(bfhi(z.w));
        *(u32x4*)(a3 + (size_t)row * PW + col) = pack8(a, b);
    }
};
struct StF32 {
    float* C; int ldc;
    __device__ __forceinline__ void store8(int row, int col, const f32x4 v0, const f32x4 v1) const { float* o = C + (size_t)row * ldc + col; *(f32x4*)o = v0; *(f32x4*)(o + 4) = v1; }
};
struct StBf16 {
    bf16* C; int ldc;
    __device__ __forceinline__ void store8(int row, int col, const f32x4 v0, const f32x4 v1) const { *(u32x4*)(C + (size_t)row * ldc + col) = pack8(v0, v1); }
};
struct StG1a {
    bf16* proj; float* out; int li;
    __device__ __forceinline__ void store8(int row, int col, const f32x4 v0, const f32x4 v1) const {
        *(u32x4*)(proj + (size_t)row * AIN + col) = pack8(v0, v1);
        if (col >= QKVW && col < 3 * QKVW) {
            int cc = col - QKVW; const int kv = cc >= QKVW ? 1 : 0; cc -= kv * QKVW; const int g = cc >> 11, he = cc & 2047, keep = 128 << (2 * g), t = row & (SEQ - 1), b = row >> 11;
            if (t >= SEQ - keep) {
                const size_t base = g == 0 ? O_KV0P : (g == 1 ? O_KV1P : O_KV2P);
                float* o = out + base + ((size_t)((li * 4 + b) * keep + (t - (SEQ - keep)))) * 4096 + kv * 2048 + he; *(f32x4*)o = v0; *(f32x4*)(o + 4) = v1;
            }
        }
    }
};

template <class S8> __device__ __forceinline__ void naive_gemm(const pg8::Gemm g, const S8& st, int gtid, int nth) {
    const int n8 = g.N / 8; const long total = (long)g.M * n8;
    for (long task = gtid; task < total; task += nth) {
        const int row = (int)(task % g.M), col = (int)(task / g.M) * 8;
        const bf16* a = g.A + (size_t)row * g.lda + (g.agrp ? (size_t)(col / (256 * g.agrp)) * g.K : (size_t)0);
        const bf16* b = g.Bt + (size_t)col * g.ldb + gemm_boff(g, row >> 8) / 2;
        float acc[8];
#pragma unroll
        for (int c = 0; c < 8; ++c) acc[c] = 0.f;
        for (int k = 0; k < g.K; k += 8) {
            const u32x4 av = *(const u32x4*)(a + k);
#pragma unroll
            for (int c = 0; c < 8; ++c) acc[c] += dot8(av, *(const u32x4*)(b + (size_t)c * g.ldb + k));
        }
        st.store8(row, col, (f32x4){acc[0], acc[1], acc[2], acc[3]}, (f32x4){acc[4], acc[5], acc[6], acc[7]});
    }
}
#ifndef MK_FAST_MASK
#define MK_FAST_MASK 31
#endif
template <int SITE, class S8> __device__ __forceinline__ void run_gemm(const Ctx& c, const pg8::Gemm g, const S8& st) {
    if constexpr (MK_NAIVE_GEMM || !((MK_FAST_MASK >> SITE) & 1)) naive_gemm(g, st, (int)blockIdx.x * NTH + c.tid, c.G * NTH);
    else {
        pg8::StaticOrder S; S.init(g.M, g.N, c.G, (int)blockIdx.x);
        Epi8<S8> E{st};
#if MK_STAGGER
        if (SITE == 0 || SITE == 3) {
            const unsigned long long t0 = __builtin_amdgcn_s_memrealtime(); const unsigned long long wt = (unsigned long long)(((blockIdx.x >> 3) & 7) * MK_STAGGER);
            while (__builtin_amdgcn_s_memrealtime() - t0 < wt) __builtin_amdgcn_s_sleep(8);
        }
#endif
        pg8::gemm_phase<Epi8<S8>, pg8::StaticOrder, true, true>((PG8_LAS unsigned char*)c.lds, g, S, E);
    }
}

template <class F> __device__ __forceinline__ void sgemm8(const Ctx& c, const bf16* As, int lda, int agrp_cols, const bf16* Wt, int N, int K, const F& epi) {
    const int q = c.lane >> 4, r = c.lane & 15, kw = K >> 3, kbeg = c.wave * kw;
    LAS float* red = (LAS float*)c.lds;
    int nslots = 0;
    for (int cg = c.vcu; cg < N / 16; cg += c.G, ++nslots) {
        const bf16* wrow = Wt + (size_t)(cg * 16 + r) * K + kbeg + q * 8;
        const bf16* arow = As + (size_t)(r & 7) * lda + (agrp_cols ? ((cg * 16) / agrp_cols) * K : 0) + kbeg + q * 8;
        pg8::f32x4 acc = {0.f, 0.f, 0.f, 0.f};
#pragma unroll 8
        for (int k0 = 0; k0 < kw; k0 += 32) {
            bf16x8 a = *(const bf16x8*)(arow + k0); if (r >= 8) a = (bf16x8){0, 0, 0, 0, 0, 0, 0, 0};
            const bf16x8 b = *(const bf16x8*)(wrow + k0);
            acc = __builtin_amdgcn_mfma_f32_16x16x32_bf16(a, b, acc, 0, 0, 0);
        }
        if (q < 2) {
#pragma unroll
            for (int j = 0; j < 4; ++j) red[(nslots * 8 + c.wave) * 128 + (q * 4 + j) * 16 + r] = acc[j];
        }
    }
    __syncthreads();
    for (int o = c.tid; o < nslots * 128; o += NTH) {
        const int sl = o >> 7, sr = (o >> 4) & 7, nn = o & 15; float sum = 0.f;
#pragma unroll
        for (int w = 0; w < 8; ++w) sum += red[(sl * 8 + w) * 128 + sr * 16 + nn];
        epi(sr, (c.vcu + sl * c.G) * 16 + nn, sum);
    }
    __syncthreads();
}

__device__ __forceinline__ void ulast_gemm(const Ctx& c, const bf16* Hrows, const bf16* Wut, float* outpool) {
    const int q = c.lane >> 4, r = c.lane & 15, kbeg = c.wave * 256, rr = r < 15 ? r : 14;
    LAS float* red = (LAS float*)c.lds;
    int nslots = 0;
    for (int cg = c.vcu; cg < PW / 16; cg += c.G, ++nslots) {
        const bf16* wrow = Wut + (size_t)(cg * 16 + r) * D + kbeg + q * 8;
        const bf16* arow = Hrows + (size_t)(SEQ - 15 + rr) * D + kbeg + q * 8;
        pg8::f32x4 acc[4];
#pragma unroll
        for (int bb = 0; bb < 4; ++bb) acc[bb] = (pg8::f32x4){0.f, 0.f, 0.f, 0.f};
#pragma unroll 2
        for (int k0 = 0; k0 < 256; k0 += 32) {
            const bf16x8 b = *(const bf16x8*)(wrow + k0);
#pragma unroll
            for (int bb = 0; bb < 4; ++bb) { const bf16x8 a = *(const bf16x8*)(arow + (size_t)bb * SEQ * D + k0); acc[bb] = __builtin_amdgcn_mfma_f32_16x16x32_bf16(a, b, acc[bb], 0, 0, 0); }
        }
#pragma unroll
        for (int bb = 0; bb < 4; ++bb)
#pragma unroll
            for (int j = 0; j < 4; ++j) red[((nslots * 8 + c.wave) * 4 + bb) * 256 + (q * 4 + j) * 16 + r] = acc[bb][j];
    }
    __syncthreads();
    for (int o = c.tid; o < nslots * 1024; o += NTH) {
        const int sl = o >> 10, bb = (o >> 8) & 3, row = (o >> 4) & 15, nn = o & 15; float sum = 0.f;
#pragma unroll
        for (int w = 0; w < 8; ++w) sum += red[((sl * 8 + w) * 4 + bb) * 256 + row * 16 + nn];
        if (row < 15) outpool[((size_t)(bb * 15 + row)) * PW + (c.vcu + sl * c.G) * 16 + nn] = sum;
    }
    __syncthreads();
}

__device__ __forceinline__ void p0_transpose_item(const float* W, int K, int N, bf16* WT, int row_off, LAS float* scr, int item, int lane, bf16* WN = nullptr, int ldn = 0) {
    const int nblk = N / 32, kb = item / nblk, nb = item % nblk, k0 = 64 * kb, n0 = 32 * nb;
#pragma unroll 8
    for (int i = 0; i < 32; ++i) { const int kk = 2 * i + (lane >> 5); scr[kk * 33 + (lane & 31)] = W[(size_t)(k0 + kk) * N + n0 + (lane & 31)]; }
    asm volatile("s_waitcnt lgkmcnt(0)" ::: "memory");
    const int cch = lane & 7;
#pragma unroll
    for (int j = 0; j < 4; ++j) { const int n = (lane >> 3) + 8 * j; const LAS float* s = scr + (8 * cch) * 33 + n;
        u32x4 o; o.x = pk2(s[0 * 33], s[1 * 33]); o.y = pk2(s[2 * 33], s[3 * 33]); o.z = pk2(s[4 * 33], s[5 * 33]); o.w = pk2(s[6 * 33], s[7 * 33]);
        *(u32x4*)(WT + (size_t)(row_off + n0 + n) * K + k0 + 8 * cch) = o; }
    if (WN) {
        const LAS float* sr = scr + lane * 33; bf16* wn = WN + (size_t)(k0 + lane) * ldn + n0;
#pragma unroll
        for (int j = 0; j < 4; ++j) { u32x4 o; o.x = pk2(sr[8 * j + 0], sr[8 * j + 1]); o.y = pk2(sr[8 * j + 2], sr[8 * j + 3]); o.z = pk2(sr[8 * j + 4], sr[8 * j + 5]); o.w = pk2(sr[8 * j + 6], sr[8 * j + 7]); *(u32x4*)(wn + 8 * j) = o; }
    }
    asm volatile("s_waitcnt lgkmcnt(0)" ::: "memory");
}
__device__ __forceinline__ void adaln_unit(const Params& p, const Ctx& c, int unit) {
    const int i = unit / 48, n0 = (unit % 48) * 128;
    LAS float* S = (LAS float*)c.lds;
    for (int idx = c.tid; idx < 12 * D; idx += NTH) { const int r = idx >> 11, k = idx & (D - 1); const float cv = r < 4 ? p.in[2][r * D + k] : p.in[3][(r - 4) * D + k]; S[idx] = silu_f(cv); }
    __syncthreads();
    float acc[12][2];
#pragma unroll
    for (int r = 0; r < 12; ++r) { acc[r][0] = 0.f; acc[r][1] = 0.f; }
    const int kb = c.wave * 256;
    const float* W = p.in[10] + ((size_t)i * D + kb) * 6144 + n0 + 2 * c.lane;
    for (int k = 0; k < 256; k += 4) {
        f32x2 w[4];
#pragma unroll
        for (int u = 0; u < 4; ++u) w[u] = *(const f32x2*)(W + (size_t)(k + u) * 6144);
#pragma unroll
        for (int r = 0; r < 12; ++r) { const f32x4 s = *(const LAS f32x4*)(S + r * D + kb + k);
            acc[r][0] += (s.x * w[0].x + s.y * w[1].x) + (s.z * w[2].x + s.w * w[3].x); acc[r][1] += (s.x * w[0].y + s.y * w[1].y) + (s.z * w[2].y + s.w * w[3].y); }
    }
    __syncthreads();
    LAS float* P = (LAS float*)c.lds;
#pragma unroll
    for (int r = 0; r < 12; ++r) { P[(c.wave * 12 + r) * 128 + 2 * c.lane] = acc[r][0]; P[(c.wave * 12 + r) * 128 + 2 * c.lane + 1] = acc[r][1]; }
    __syncthreads();
    float* MOD = (float*)(p.ws + WS_MOD);
    for (int o = c.tid; o < 12 * 128; o += NTH) { const int r = o >> 7, n = o & 127; float s = 0.f;
#pragma unroll
        for (int w = 0; w < 8; ++w) s += P[(w * 12 + r) * 128 + n];
        MOD[(size_t)(i * 12 + r) * 6144 + n0 + n] = s + p.in[11][i * 6144 + n0 + n]; }
    __syncthreads();
}
__device__ __forceinline__ void phase_prologue(const Params& p, const Ctx& c) {
    for (int unit = c.vcu; unit < 192; unit += c.G) adaln_unit(p, c, unit);
    if (c.vcu == c.G - 1) {
        float* BIAS = (float*)(p.ws + WS_BIAS);
        for (int idx = c.tid; idx < 48 * 129; idx += NTH) { const int sh = idx / 129, j = idx % 129, g = sh >> 4, dist = j << (2 * g); int bucket;
            if (dist < 16) bucket = dist; else { const int large = 16 + (int)(log((double)dist / 16.0) / log(128.0) * 16.0); bucket = large < 31 ? large : 31; }
            BIAS[sh * 132 + j] = p.in[12][bucket * 48 + sh]; }
    }
    LAS float* scr = (LAS float*)(c.lds + c.wave * 16384);
    constexpr int I_PI = 32 * 256, I_PG = 16 * 32, I_PO = 64 * 64, I_AI = 32 * 640, I_AO = 32 * 64, I_LAYER = I_PI + 4 * I_PG + I_PO + I_AI + I_AO;
    for (int it = c.gw; it < 2 * I_LAYER; it += c.NGW) {
        const int li = it / I_LAYER; int r = it % I_LAYER;
        if (r < I_PI) {
            const bool isu = (r % 256) < 128;
            if (isu) p0_transpose_item(p.in[13] + (size_t)li * D * PIN, D, PIN, (bf16*)(p.ws + WS_WUT) + (size_t)li * PW * D, 0, scr, r, c.lane, (bf16*)(p.ws + WS_WUN) + (size_t)li * D * PW, PW);
            else p0_transpose_item(p.in[13] + (size_t)li * D * PIN, D, PIN, (bf16*)(p.ws + WS_WG1) + (size_t)li * PIN * D, 0, scr, r, c.lane);
            continue; } r -= I_PI;
        if (r < 4 * I_PG) { const int g = r / I_PG; p0_transpose_item(p.in[14] + (size_t)(li * 4 + g) * 1024 * 1024, 1024, 1024, (bf16*)(p.ws + WS_WPG) + (size_t)li * PW * 1024, g * 1024, scr, r % I_PG, c.lane); continue; } r -= 4 * I_PG;
        if (r < I_PO) { p0_transpose_item(p.in[16] + (size_t)li * PW * D, PW, D, (bf16*)(p.ws + WS_WPO) + (size_t)li * D * PW, 0, scr, r, c.lane); continue; } r -= I_PO;
        if (r < I_AI) { p0_transpose_item(p.in[17] + (size_t)li * D * AIN, D, AIN, (bf16*)(p.ws + WS_WAI) + (size_t)li * AIN * D, 0, scr, r, c.lane); continue; } r -= I_AI;
        p0_transpose_item(p.in[18] + (size_t)li * D * D, D, D, (bf16*)(p.ws + WS_WAO) + (size_t)li * D * D, 0, scr, r, c.lane);
    }
}

__device__ __forceinline__ void phase_norm(const Params& p, const Ctx& c, int i) {
    const float* MOD = (const float*)(p.ws + WS_MOD); const float* Y = (const float*)(p.ws + WS_Y); bf16* H = (bf16*)(p.ws + WS_H);
    for (int row = c.gw; row < MROWS + NS; row += c.NGW) {
        const bool smp = row >= MROWS; const int b = smp ? row - MROWS : row >> 11, mr = smp ? 4 + b : b;
        float* xo = smp ? p.out + O_YS + (size_t)b * D : p.out + O_YP + (size_t)row * D;
        const float* xi = (i <= 1) ? (smp ? p.in[1] + (size_t)b * D : p.in[0] + (size_t)row * D) : xo;
        f32x4 v[8];
#pragma unroll
        for (int j = 0; j < 8; ++j) v[j] = ((const f32x4*)xi)[c.lane + 64 * j];
        if (i > 0) {
            f32x4 y[8]; float ss = 0.f;
#pragma unroll
            for (int j = 0; j < 8; ++j) {
                if (smp) y[j] = ((const f32x4*)(Y + (size_t)row * D))[c.lane + 64 * j];
                else { const u32x2 yw = ((const u32x2*)((const bf16*)Y + (size_t)row * D))[c.lane + 64 * j]; y[j] = (f32x4){bflo(yw.x), bfhi(yw.x), bflo(yw.y), bfhi(yw.y)}; }
                ss += (y[j].x * y[j].x + y[j].y * y[j].y) + (y[j].z * y[j].z + y[j].w * y[j].w); }
            const float rstd = 1.0f / sqrtf(wave_sum(ss) * (1.0f / D) + RMS_EPS);
            const f32x4* gate = (const f32x4*)(MOD + (size_t)((i - 1) * 12 + mr) * 6144 + 4096); const f32x4* npo = (const f32x4*)(p.in[9] + (size_t)(i - 1) * D);
#pragma unroll
            for (int j = 0; j < 8; ++j) { const f32x4 g4 = gate[c.lane + 64 * j], n4 = npo[c.lane + 64 * j]; v[j] = v[j] + g4 * (y[j] * rstd * n4); ((f32x4*)xo)[c.lane + 64 * j] = v[j]; }
        }
        if (i < 4) {
            float ss = 0.f;
#pragma unroll
            for (int j = 0; j < 8; ++j) ss += (v[j].x * v[j].x + v[j].y * v[j].y) + (v[j].z * v[j].z + v[j].w * v[j].w);
            const float rstd = 1.0f / sqrtf(wave_sum(ss) * (1.0f / D) + RMS_EPS);
            const f32x4* sh = (const f32x4*)(MOD + (size_t)(i * 12 + mr) * 6144); const f32x4* sc = sh + 512; const f32x4* npr = (const f32x4*)(p.in[8] + (size_t)i * D);
            u32x2* ho = (u32x2*)(H + (size_t)row * D);
#pragma unroll
            for (int j = 0; j < 8; ++j) { const f32x4 s4 = sc[c.lane + 64 * j], h4 = sh[c.lane + 64 * j], n4 = npr[c.lane + 64 * j]; const f32x4 h = v[j] * rstd * n4 * (1.0f + s4) + h4;
                u32x2 w; w.x = pk2(h.x, h.y); w.y = pk2(h.z, h.w); ho[c.lane + 64 * j] = w; }
        }
    }
}

__device__ __forceinline__ void w_acc(float (&S)[8], const u32x4 x, const float sgn) {
    S[0] += sgn * bflo(x.x); S[1] += sgn * bfhi(x.x); S[2] += sgn * bflo(x.y); S[3] += sgn * bfhi(x.y); S[4] += sgn * bflo(x.z); S[5] += sgn * bfhi(x.z); S[6] += sgn * bflo(x.w); S[7] += sgn * bfhi(x.w);
}
template <int W> __device__ __forceinline__ void window_task(const bf16* up  , bf16* ap, const float* scale, const int t0) {
    u32x4 ring[W]; float S[8];
#pragma unroll
    for (int e = 0; e < 8; ++e) S[e] = 0.f;
    ring[0] = (u32x4){0u, 0u, 0u, 0u};
#pragma unroll
    for (int r = 1; r < W; ++r) { if (t0 > 0) { ring[r] = *(const u32x4*)(up - (size_t)(W - r) * PIN); w_acc(S, ring[r], 1.0f); } else ring[r] = (u32x4){0u, 0u, 0u, 0u}; }
    const f32x4 s0 = *(const f32x4*)scale, s1 = *(const f32x4*)(scale + 4);
#pragma unroll
    for (int tt = 0; tt < 32; tt += W)
#pragma unroll
        for (int r = 0; r < W; ++r) {
            const int t = tt + r;
            const u32x4 x = *(const u32x4*)(up + (size_t)t * PIN), z = *(const u32x4*)(up + (size_t)t * PIN + PW);
            w_acc(S, x, 1.0f); w_acc(S, ring[r], -1.0f); ring[r] = x;
            const float inv = (t < W - 1 && t0 == 0) ? 1.0f / (float)(t + 1) : 1.0f / (float)W;
            u32x4 o;
            o.x = cvt_pk_bf16((S[0] * inv - bflo(x.x)) * s0.x * silu_f(bflo(z.x)), (S[1] * inv - bfhi(x.x)) * s0.y * silu_f(bfhi(z.x)));
            o.y = cvt_pk_bf16((S[2] * inv - bflo(x.y)) * s0.z * silu_f(bflo(z.y)), (S[3] * inv - bfhi(x.y)) * s0.w * silu_f(bfhi(z.y)));
            o.z = cvt_pk_bf16((S[4] * inv - bflo(x.z)) * s1.x * silu_f(bflo(z.z)), (S[5] * inv - bfhi(x.z)) * s1.y * silu_f(bfhi(z.z)));
            o.w = cvt_pk_bf16((S[6] * inv - bflo(x.w)) * s1.z * silu_f(bflo(z.w)), (S[7] * inv - bfhi(x.w)) * s1.w * silu_f(bfhi(z.w)));
            *(u32x4*)(ap + (size_t)t * PW) = o;
        }
}
__device__ __forceinline__ void phase_window(const Params& p, const Ctx& c, int li) {
    const bf16* proj = (const bf16*)(p.ws + WS_PROJ); bf16* A3 = (bf16*)(p.ws + WS_A3); const float* scale = p.in[15] + (size_t)li * PW;
    for (int task = c.vcu * NTH + c.tid; task < (MROWS / 32) * 512; task += c.G * NTH) {
        const int row0 = (task >> 9) * 32, col = (task & 511) * 8, g = col >> 10, t0 = row0 & (SEQ - 1);
        const bf16* up = proj + (size_t)row0 * PIN + col; bf16* ap = A3 + (size_t)row0 * PW + col;
        if (g == 0) window_task<2>(up, ap, scale + col, t0); else if (g == 1) window_task<4>(up, ap, scale + col, t0); else if (g == 2) window_task<8>(up, ap, scale + col, t0); else window_task<16>(up, ap, scale + col, t0);
    }
}

__device__ __forceinline__ void phase_attention_naive(const Params& p, const Ctx& c, int li) {
    const bf16* proj = (const bf16*)(p.ws + WS_PROJ); const float* BIAS = (const float*)(p.ws + WS_BIAS); bf16* A2 = (bf16*)(p.ws + WS_A3);
    LAS float* qs = (LAS float*)(c.lds + c.wave * 2048); LAS float* ps = qs + 128;
    for (int task = c.gw; task < MROWS * 16; task += c.NGW) {
        const int row = task >> 4, h = task & 15, t = row & (SEQ - 1);
        float og0[3], og1[3], lse[3];
#pragma unroll
        for (int g = 0; g < 3; ++g) {
            const int dil = 1 << (2 * g), nk = (t / dil) < 128 ? (t / dil) : 128;
            { const unsigned qw = *(const unsigned*)(proj + (size_t)row * AIN + g * 2048 + h * 128 + 2 * c.lane); qs[2 * c.lane] = bflo(qw); qs[2 * c.lane + 1] = bfhi(qw); }
            asm volatile("s_waitcnt lgkmcnt(0)" ::: "memory");
            float s[3], pj[3];
#pragma unroll
            for (int jj = 0; jj < 3; ++jj) {
                const int j = c.lane + 64 * jj; const bool valid = (jj < 2 || c.lane == 0) && j <= nk; float sc = NEG_INF;
                if (valid) { const bf16* kp = proj + (size_t)(row - j * dil) * AIN + QKVW + g * 2048 + h * 128; float dot = 0.f;
#pragma unroll
                    for (int ch = 0; ch < 16; ++ch) { const u32x4 kv = *(const u32x4*)(kp + 8 * ch); const f32x4 q0 = *(const LAS f32x4*)(qs + 8 * ch), q1 = *(const LAS f32x4*)(qs + 8 * ch + 4);
                        dot += (bflo(kv.x) * q0.x + bfhi(kv.x) * q0.y) + (bflo(kv.y) * q0.z + bfhi(kv.y) * q0.w) + (bflo(kv.z) * q1.x + bfhi(kv.z) * q1.y) + (bflo(kv.w) * q1.z + bfhi(kv.w) * q1.w); }
                    sc = dot * ATT_SCALE + BIAS[(g * 16 + h) * 132 + j]; }
                s[jj] = sc;
            }
            const float m = wave_max(fmaxf(fmaxf(s[0], s[1]), s[2]));
            float lsum = 0.f;
#pragma unroll
            for (int jj = 0; jj < 3; ++jj) { const int j = c.lane + 64 * jj; const bool valid = (jj < 2 || c.lane == 0) && j <= nk; pj[jj] = valid ? __expf(s[jj] - m) : 0.f; lsum += pj[jj]; if (jj < 2 || c.lane == 0) ps[j] = pj[jj]; }
            const float l = wave_sum(lsum);
            asm volatile("s_waitcnt lgkmcnt(0)" ::: "memory");
            float o0 = 0.f, o1 = 0.f;
            for (int j = 0; j <= nk; ++j) { const float pv = ps[j]; const unsigned vw = *(const unsigned*)(proj + (size_t)(row - j * dil) * AIN + 2 * QKVW + g * 2048 + h * 128 + 2 * c.lane); o0 += pv * bflo(vw); o1 += pv * bfhi(vw); }
            og0[g] = o0 / l; og1[g] = o1 / l; lse[g] = m + __logf(l);
            asm volatile("s_waitcnt lgkmcnt(0)" ::: "memory");
        }
        const float mm = fmaxf(fmaxf(lse[0], lse[1]), lse[2]); const float w0 = __expf(lse[0] - mm), w1 = __expf(lse[1] - mm), w2 = __expf(lse[2] - mm), wi = 1.0f / (w0 + w1 + w2);
        const unsigned zw = *(const unsigned*)(proj + (size_t)row * AIN + 3 * QKVW + h * 128 + 2 * c.lane);
        const float r0 = (w0 * og0[0] + w1 * og0[1] + w2 * og0[2]) * wi * silu_f(bflo(zw)), r1 = (w0 * og1[0] + w1 * og1[1] + w2 * og1[2]) * wi * silu_f(bfhi(zw));
        *(unsigned*)(A2 + (size_t)row * D + h * 128 + 2 * c.lane) = pk2(r0, r1);
    }
}
__device__ __forceinline__ void phase_attention_sample(const Params& p, const Ctx& c, int li) {
    const float* PS = (const float*)(p.ws + WS_PS); const float* BIAS = (const float*)(p.ws + WS_BIAS);
    float* OGS = (float*)(p.ws + WS_OGS); float* LSES = (float*)(p.ws + WS_LSES);
    const int grp = c.lane >> 4, l16 = c.lane & 15;
    for (int task = c.gw; task < NS * 3 * 16 * 4; task += c.NGW) {
        const int ks = task & 3, h = (task >> 2) & 15, g = (task >> 6) % 3, b = task / 192;
        const int dil = 1 << (2 * g), L = 128 << (2 * g), j0 = 33 * ks, j1 = (j0 + 33) < 129 ? (j0 + 33) : 129;
        const float* cache = p.in[4 + g] + ((size_t)(li * NS + b) * L) * 4096 + h * 128;
        const float* pk0 = PS + (size_t)b * AIN + QKVW + g * 2048 + h * 128; const float* pv0 = pk0 + QKVW;
        const float* qp = PS + (size_t)b * AIN + g * 2048 + h * 128 + 8 * l16;
        const f32x4 q0 = *(const f32x4*)qp, q1 = *(const f32x4*)(qp + 4);
        float sc[9];
#pragma unroll
        for (int it = 0; it < 9; ++it) {
            const int j = j0 + 4 * it + grp; float dot = 0.f;
            if (j < j1) { const float* kp = (j == 0 ? pk0 : cache + (size_t)(L - j * dil) * 4096) + 8 * l16; const f32x4 k0 = *(const f32x4*)kp, k1 = *(const f32x4*)(kp + 4);
                dot = (k0.x * q0.x + k0.y * q0.y) + (k0.z * q0.z + k0.w * q0.w) + (k1.x * q1.x + k1.y * q1.y) + (k1.z * q1.z + k1.w * q1.w); }
            dot += __shfl_xor(dot, 1); dot += __shfl_xor(dot, 2); dot += __shfl_xor(dot, 4); dot += __shfl_xor(dot, 8);
            sc[it] = (j < j1) ? dot * ATT_SCALE + BIAS[(g * 16 + h) * 132 + j] : NEG_INF;
        }
        float m = sc[0];
#pragma unroll
        for (int it = 1; it < 9; ++it) m = fmaxf(m, sc[it]);
        m = fmaxf(m, __shfl_xor(m, 16)); m = fmaxf(m, __shfl_xor(m, 32));
        float lsum = 0.f;
#pragma unroll
        for (int it = 0; it < 9; ++it) { const int j = j0 + 4 * it + grp; sc[it] = (j < j1) ? __expf(sc[it] - m) : 0.f; lsum += sc[it]; }
        lsum += __shfl_xor(lsum, 16); lsum += __shfl_xor(lsum, 32);
        LAS float* ps = (LAS float*)(c.lds + c.wave * 256);
#pragma unroll
        for (int it = 0; it < 9; ++it) if (l16 == 0) ps[4 * it + grp] = sc[it];
        asm volatile("s_waitcnt lgkmcnt(0)" ::: "memory");
        float o0 = 0.f, o1 = 0.f;
#pragma unroll 4
        for (int j = j0; j < j1; ++j) { const float pj = ps[j - j0]; const float* vp = (j == 0 ? pv0 : cache + (size_t)(L - j * dil) * 4096 + 2048) + 2 * c.lane; const f32x2 vv = *(const f32x2*)vp; o0 += pj * vv.x; o1 += pj * vv.y; }
        asm volatile("s_waitcnt lgkmcnt(0)" ::: "memory");
        const float inv = 1.0f / lsum; const int part = g * 4 + ks;
        *(f32x2*)(OGS + ((size_t)(b * 12 + part)) * D + h * 128 + 2 * c.lane) = (f32x2){o0 * inv, o1 * inv};
        if (c.lane == 0) LSES[(b * 12 + part) * 16 + h] = m + __logf(lsum);
    }
}
__device__ __forceinline__ void phase_combine_sample(const Params& p, const Ctx& c) {
    const float* PS = (const float*)(p.ws + WS_PS); const float* OGS = (const float*)(p.ws + WS_OGS); const float* LSES = (const float*)(p.ws + WS_LSES); bf16* A2S = (bf16*)(p.ws + WS_A3S);
    for (int o = c.vcu * NTH + c.tid; o < NS * D; o += c.G * NTH) {
        const int b = o >> 11, col = o & (D - 1), h = col >> 7;
        float ls[12], mm = NEG_INF;
#pragma unroll
        for (int k = 0; k < 12; ++k) { ls[k] = LSES[(b * 12 + k) * 16 + h]; mm = fmaxf(mm, ls[k]); }
        float ws = 0.f, acc = 0.f;
#pragma unroll
        for (int k = 0; k < 12; ++k) { const float wk = __expf(ls[k] - mm); ws += wk; acc += wk * OGS[((size_t)(b * 12 + k)) * D + col]; }
        A2S[(size_t)b * D + col] = (bf16)f2bf(acc / ws * silu_f(PS[(size_t)b * AIN + 3 * QKVW + col]));
    }
}

typedef float f32x16 __attribute__((ext_vector_type(16)));
typedef short v4i16_t __attribute__((ext_vector_type(4)));
constexpr int ATT_TAB_OFF = RING_BYTES + 1024;
__device__ __forceinline__ unsigned att_off(unsigned row, unsigned ch) { return 256u * row + 16u * (ch ^ (((row & 3u) << 2) | ((row >> 2) & 3u))); }
__device__ __forceinline__ void att_stage(const Ctx& c, const bf16* src_base  , int b, int dil, int res, int i0) {
    const int rin = c.lane >> 4, slot = c.lane & 15;
    const bf16* src0 = src_base + (size_t)(b * SEQ + res) * AIN;
#pragma unroll
    for (int i = 0; i < 16; ++i) {
        const int k = ((64 * c.wave) & 255) + 4 * i + rin;
        int sub = i0 - 128 + k; sub = sub < 0 ? 0 : sub;
        const int ch = slot ^ ((rin << 2) | (i & 3));
        __builtin_amdgcn_global_load_lds((const unsigned*)(src0 + (size_t)(sub * dil) * AIN + ch * 8), (LAS unsigned*)(c.lds + (64 * c.wave + 4 * i) * 256), 16, 0, 0);
    }
}
__device__ __forceinline__ void phase_attention(const Params& p, const Ctx& c, int li) {
    const bf16* proj = (const bf16*)(p.ws + WS_PROJ); const float* BIAS = (const float*)(p.ws + WS_BIAS);
    bf16* OG = (bf16*)(p.ws + WS_OG); float* LSE = (float*)(p.ws + WS_LSE);
    LAS float* tab = (LAS float*)(c.lds + ATT_TAB_OFF);
    const int w = c.wave, seg = w >> 2, a = w & 3, lane = c.lane, q = lane & 31, hh = lane >> 5;
    unsigned kb[8], vb[4][2];
    { const unsigned krow = (unsigned)(seg * 256 + 32 * a + q);
#pragma unroll
      for (int s = 0; s < 8; ++s) kb[s] = att_off(krow, 2 * s + hh);
      const unsigned qq = (lane & 15) >> 2, pp = lane & 3, blk = (lane >> 4) & 1, vrow = (unsigned)(seg * 256 + 32 * a) + 4 * hh + qq;
#pragma unroll
      for (int dt = 0; dt < 4; ++dt)
#pragma unroll
          for (int t = 0; t < 2; ++t) vb[dt][t] = att_off(vrow + 8 * t, 4 * dt + 2 * blk + (pp >> 1)) + 8 * (pp & 1); }
    const LAS float* tl = tab + (32 + 4 * hh - q);
    for (int unit = c.vcu; unit < 1536; unit += c.G) {
        const int u = unit & 7, h = (unit >> 3) & 15, g = (unit >> 7) % 3, b = unit / 384, dil = 1 << (2 * g);
        int res, i0;
        if (g == 0) { res = 0; i0 = 256 * u + 128 * seg; }
        else if (g == 1) { res = u >> 1; i0 = 256 * (u & 1) + 128 * seg; }
        else { res = 2 * u + seg; i0 = 0; }
        const int kt_lo = (i0 == 0) ? 4 - a : 0;
        __syncthreads();
        att_stage(c, proj + QKVW + g * 2048 + h * 128, b, dil, res, i0);
        if (c.tid < 192) { const int x = c.tid; tab[x] = (x >= 32 && x <= 160) ? BIAS[(g * 16 + h) * 132 + (160 - x)] : NEG_INF; }
        const size_t qrow = (size_t)b * SEQ + (size_t)(i0 + 32 * a + q) * dil + res;
        bf16x8 qf[8];
#pragma unroll
        for (int s = 0; s < 8; ++s) qf[s] = *(const bf16x8*)(proj + qrow * AIN + g * 2048 + h * 128 + 16 * s + 8 * hh);
        asm volatile("s_waitcnt vmcnt(0) lgkmcnt(0)" ::: "memory");
        __syncthreads();
        f32x16 S[5];
        float mx = NEG_INF;
#pragma unroll
        for (int kt = 0; kt < 5; ++kt) {
            if (kt >= kt_lo) {
                f32x16 acc;
#pragma unroll
                for (int e = 0; e < 16; ++e) acc[e] = 0.f;
#pragma unroll
                for (int s = 0; s < 8; ++s) { const bf16x8 kf = *(const LAS bf16x8*)(c.lds + kb[s] + 8192 * kt); acc = __builtin_amdgcn_mfma_f32_32x32x16_bf16(kf, qf[s], acc, 0, 0, 0); }
#pragma unroll
                for (int e = 0; e < 16; ++e) { acc[e] = acc[e] * ATT_SCALE + tl[32 * kt + 8 * (e >> 2) + (e & 3)]; mx = fmaxf(mx, acc[e]); }
                S[kt] = acc;
            } else {
#pragma unroll
                for (int e = 0; e < 16; ++e) S[kt][e] = NEG_INF;
            }
            __builtin_amdgcn_sched_barrier(0);
        }
        mx = fmaxf(mx, __shfl_xor(mx, 32));
        float lsum = 0.f; bf16x8 pf[5][2];
#pragma unroll
        for (int kt = 0; kt < 5; ++kt) {
            float pe[16];
#pragma unroll
            for (int e = 0; e < 16; ++e) { pe[e] = __expf(S[kt][e] - mx); lsum += pe[e]; }
#pragma unroll
            for (int s2 = 0; s2 < 2; ++s2) { u32x4 pk; pk.x = cvt_pk_bf16(pe[8 * s2 + 0], pe[8 * s2 + 1]); pk.y = cvt_pk_bf16(pe[8 * s2 + 2], pe[8 * s2 + 3]); pk.z = cvt_pk_bf16(pe[8 * s2 + 4], pe[8 * s2 + 5]); pk.w = cvt_pk_bf16(pe[8 * s2 + 6], pe[8 * s2 + 7]);
                pf[kt][s2] = __builtin_bit_cast(bf16x8, pk); }
            __builtin_amdgcn_sched_barrier(0);
        }
        lsum += __shfl_xor(lsum, 32);
        __syncthreads();
        att_stage(c, proj + 2 * QKVW + g * 2048 + h * 128, b, dil, res, i0);
        asm volatile("s_waitcnt vmcnt(0)" ::: "memory");
        __syncthreads();
        const float inv = 1.0f / lsum;
        bf16* orow = OG + (size_t)g * MROWS * D + qrow * D + h * 128 + 4 * hh;
#pragma unroll
        for (int dt = 0; dt < 4; ++dt) {
            f32x16 O;
#pragma unroll
            for (int e = 0; e < 16; ++e) O[e] = 0.f;
#pragma unroll
            for (int kt = 0; kt < 5; ++kt) {
                if (kt >= kt_lo) {
#pragma unroll
                    for (int s2 = 0; s2 < 2; ++s2) {
                        const v4i16_t v0 = __builtin_amdgcn_ds_read_tr16_b64_v4i16((LAS v4i16_t*)(c.lds + vb[dt][0] + 256 * (32 * kt + 16 * s2)));
                        const v4i16_t v1 = __builtin_amdgcn_ds_read_tr16_b64_v4i16((LAS v4i16_t*)(c.lds + vb[dt][1] + 256 * (32 * kt + 16 * s2)));
                        const bf16x8 vf = {v0[0], v0[1], v0[2], v0[3], v1[0], v1[1], v1[2], v1[3]};
                        O = __builtin_amdgcn_mfma_f32_32x32x16_bf16(vf, pf[kt][s2], O, 0, 0, 0);
                    }
                }
            }
#pragma unroll
            for (int i4 = 0; i4 < 4; ++i4) { u32x2 o; o.x = cvt_pk_bf16(O[4 * i4 + 0] * inv, O[4 * i4 + 1] * inv); o.y = cvt_pk_bf16(O[4 * i4 + 2] * inv, O[4 * i4 + 3] * inv);
                *(u32x2*)(orow + 32 * dt + 8 * i4) = o; }
            __builtin_amdgcn_sched_barrier(0);
        }
        if (hh == 0) LSE[((size_t)g * MROWS + qrow) * 16 + h] = mx + __logf(lsum);
    }
    __syncthreads();
}
__device__ __forceinline__ void phase_combine(const Params& p, const Ctx& c) {
    const bf16* proj = (const bf16*)(p.ws + WS_PROJ); const bf16* OG = (const bf16*)(p.ws + WS_OG); const float* LSE = (const float*)(p.ws + WS_LSE); bf16* A2 = (bf16*)(p.ws + WS_A3);
    for (int task = c.vcu * NTH + c.tid; task < MROWS * 256; task += c.G * NTH) {
        const int row = task >> 8, ch = task & 255, h = ch >> 4;
        const float l0 = LSE[(size_t)row * 16 + h], l1 = LSE[((size_t)MROWS + row) * 16 + h], l2 = LSE[((size_t)2 * MROWS + row) * 16 + h];
        const float mm = fmaxf(fmaxf(l0, l1), l2); float w0 = __expf(l0 - mm), w1 = __expf(l1 - mm), w2 = __expf(l2 - mm); const float wi = 1.0f / (w0 + w1 + w2); w0 *= wi; w1 *= wi; w2 *= wi;
        const u32x4 o0 = *(const u32x4*)(OG + (size_t)row * D + ch * 8), o1 = *(const u32x4*)(OG + ((size_t)MROWS + row) * D + ch * 8), o2 = *(const u32x4*)(OG + ((size_t)2 * MROWS + row) * D + ch * 8);
        const u32x4 z = *(const u32x4*)(proj + (size_t)row * AIN + 3 * QKVW + ch * 8);
        u32x4 r;
        r.x = pk2((w0 * bflo(o0.x) + w1 * bflo(o1.x) + w2 * bflo(o2.x)) * silu_f(bflo(z.x)), (w0 * bfhi(o0.x) + w1 * bfhi(o1.x) + w2 * bfhi(o2.x)) * silu_f(bfhi(z.x)));
        r.y = pk2((w0 * bflo(o0.y) + w1 * bflo(o1.y) + w2 * bflo(o2.y)) * silu_f(bflo(z.y)), (w0 * bfhi(o0.y) + w1 * bfhi(o1.y) + w2 * bfhi(o2.y)) * silu_f(bfhi(z.y)));
        r.z = pk2((w0 * bflo(o0.z) + w1 * bflo(o1.z) + w2 * bflo(o2.z)) * silu_f(bflo(z.z)), (w0 * bfhi(o0.z) + w1 * bfhi(o1.z) + w2 * bfhi(o2.z)) * silu_f(bfhi(z.z)));
        r.w = pk2((w0 * bflo(o0.w) + w1 * bflo(o1.w) + w2 * bflo(o2.w)) * silu_f(bflo(z.w)), (w0 * bfhi(o0.w) + w1 * bfhi(o1.w) + w2 * bfhi(o2.w)) * silu_f(bfhi(z.w)));
        *(u32x4*)(A2 + (size_t)row * D + ch * 8) = r;
    }
}

__global__ void __launch_bounds__(NTH, 2) mega_fwd(Params p) {
    extern __shared__ __attribute__((aligned(16))) unsigned char lds_raw[];
    Ctx c;
    c.lds = (LAS unsigned char*)lds_raw;
    c.tid = threadIdx.x; c.lane = c.tid & 63; c.wave = __builtin_amdgcn_readfirstlane(c.tid >> 6);
    c.G = gridDim.x; { const int bx = blockIdx.x; c.vcu = (c.G % 8 == 0) ? (bx % 8) * (c.G / 8) + bx / 8 : bx; }
    c.gw = c.vcu * NWAVES + c.wave; c.NGW = c.G * NWAVES;
    volatile LAS unsigned* MISC = (volatile LAS unsigned*)(c.lds + MISC_OFF);
    for (int u = c.tid; u < (LDS_BYTES - LDSCTL_OFF) / 4; u += NTH) ((LAS unsigned*)(c.lds + LDSCTL_OFF))[u] = 0u;
    __syncthreads();
    unsigned* ctl = (unsigned*)(p.ws + WS_CTL);
    XcdBarrier bar; bar.bar = ctl + CW_BAR; bar.x = 0; bar.st = nullptr;
    const int lo = p.ph_lo, hi = p.ph_hi;
    if (hi - lo > 1) bar = xcd_barrier_post(ctl + CW_BAR, MISC + 8);
#define IN(k) (lo <= (k) && (k) < hi)
#define SEAM(k) do { if (IN(k) && IN((k) + 1)) xcd_barrier(bar); } while (0)
    bf16* const H = (bf16*)(p.ws + WS_H); bf16* const PROJ = (bf16*)(p.ws + WS_PROJ); bf16* const A3 = (bf16*)(p.ws + WS_A3);
    bf16* const YB = (bf16*)(p.ws + WS_Y);
    float* const Y = (float*)(p.ws + WS_Y); float* const PS = (float*)(p.ws + WS_PS); bf16* const RS = (bf16*)(p.ws + WS_RS); bf16* const A3S = (bf16*)(p.ws + WS_A3S);

    if (IN(0)) REPS(0) { phase_prologue(p, c); if (MK_REP_KIND == 0) __syncthreads(); }
    SEAM(0);
    if (IN(1)) {
        run_gemm<1>(c, pg8::Gemm{(const bf16*)(p.ws + WS_WPG), (const bf16*)(p.ws + WS_WUN), 2 * PW, D, 1024, 1024, 0, PW, 1}, StWg1{(bf16*)(p.ws + WS_WG1)});
    }
    SEAM(1);
    const Ctx c0 = c;
    for (int i = 0; i < 4; ++i) {
        const int ph = 2 + 5 * i, li = i >> 1;
        Ctx c = c0; asm volatile("" : "+v"(c.tid), "+v"(c.lane), "+s"(c.gw), "+s"(c.vcu), "+s"(c.wave));
        if (IN(ph)) phase_norm(p, c, i);
        SEAM(ph);
        if (!(i & 1)) {
            const bf16* Wg1 = (const bf16*)(p.ws + WS_WG1) + (size_t)li * PIN * D; const bf16* Wut = (const bf16*)(p.ws + WS_WUT) + (size_t)li * PW * D;
            const bf16* Wpg = (const bf16*)(p.ws + WS_WPG) + (size_t)li * PW * 1024; const bf16* Wpo = (const bf16*)(p.ws + WS_WPO) + (size_t)li * D * PW;
            const float* scale = p.in[15] + (size_t)li * PW;
            if (IN(ph + 1)) REPS(2) {
                const float* st0 = p.in[7] + (size_t)li * NS * 15 * PW; float* po0 = p.out + O_POOLS + (size_t)li * NS * 15 * PW;
                sgemm8(c, H + (size_t)MROWS * D, D, 0, Wut, PW, D, [&](int s, int n, float v) {
                    const int w = 2 << (n >> 10); const float* st = st0 + (size_t)s * 15 * PW + n; float* po = po0 + (size_t)s * 15 * PW + n; float sum = v;
                    for (int j = 16 - w; j < 15; ++j) sum += st[(size_t)j * PW];
                    for (int j = 0; j < 14; ++j) po[(size_t)j * PW] = st[(size_t)(j + 1) * PW];
                    po[(size_t)14 * PW] = v;
                    RS[(size_t)s * PW + n] = (bf16)f2bf(sum / (float)w - v); });
                sgemm8(c, H + (size_t)MROWS * D, D, 0, Wg1 + (size_t)PW * D, PW, D, [&](int s, int n, float v) { PS[(size_t)s * PIN + PW + n] = v; });
                ulast_gemm(c, H, Wut, p.out + O_POOLP + (size_t)li * 4 * 15 * PW);
                run_gemm<0>(c, pg8::Gemm{H, Wg1, MROWS, PIN, D, D, 0, D, 0}, StBf16{PROJ, PIN});
            }
            SEAM(ph + 1);
            if (IN(ph + 2)) REPS(3) {
                sgemm8(c, RS, PW, 1024, Wpg, PW, 1024, [&](int s, int n, float v) { A3S[(size_t)s * PW + n] = (bf16)f2bf(v * scale[n] * silu_f(PS[(size_t)s * PIN + PW + n])); });
                phase_window(p, c, li);
            }
            SEAM(ph + 2);
            if (IN(ph + 4)) REPS(5) {
                sgemm8(c, A3S, PW, 0, Wpo, D, PW, [&](int s, int n, float v) { Y[(size_t)(MROWS + s) * D + n] = v; });
                run_gemm<2>(c, pg8::Gemm{A3, Wpo, MROWS, D, PW, PW, 0, PW, 0}, StBf16{YB, D});
            }
            SEAM(ph + 4);
        } else {
            const bf16* Wai = (const bf16*)(p.ws + WS_WAI) + (size_t)li * AIN * D; const bf16* Wao = (const bf16*)(p.ws + WS_WAO) + (size_t)li * D * D;
            if (IN(ph + 1)) REPS(6) {
                float* const out = p.out;
                sgemm8(c, H + (size_t)MROWS * D, D, 0, Wai, AIN, D, [&](int s, int n, float v) {
                    PS[(size_t)s * AIN + n] = v;
                    if (n >= QKVW && n < 3 * QKVW) { int cc = n - QKVW; const int kv = cc >= QKVW ? 1 : 0; cc -= kv * QKVW; const int g = cc >> 11, he = cc & 2047;
                        const size_t base = g == 0 ? O_KV0S : (g == 1 ? O_KV1S : O_KV2S); out[base + (size_t)(li * NS + s) * 4096 + kv * 2048 + he] = v; } });
                run_gemm<3>(c, pg8::Gemm{H, Wai, MROWS, AIN, D, D, 0, D, 0}, StG1a{PROJ, p.out, li});
            }
            SEAM(ph + 1);
#if MK_NAIVE_ATT
            if (IN(ph + 2)) { phase_attention_naive(p, c, li); phase_attention_sample(p, c, li); }
            SEAM(ph + 2);
#else
            if (IN(ph + 2)) { phase_attention_sample(p, c, li); REPS(7) phase_attention(p, c, li); }
            SEAM(ph + 2);
            if (IN(ph + 3)) REPS(8) { phase_combine_sample(p, c); phase_combine(p, c); }
            SEAM(ph + 3);
#endif
            if (IN(ph + 4)) REPS(9) {
                sgemm8(c, A3S, D, 0, Wao, D, D, [&](int s, int n, float v) { Y[(size_t)(MROWS + s) * D + n] = v; });
                run_gemm<4>(c, pg8::Gemm{A3, Wao, MROWS, D, D, D, 0, D, 0}, StBf16{YB, D});
            }
            SEAM(ph + 4);
        }
    }
    if (IN(22)) { Ctx c = c0; asm volatile("" : "+v"(c.tid), "+v"(c.lane), "+s"(c.gw), "+s"(c.vcu), "+s"(c.wave)); phase_norm(p, c, 4); }
#undef IN
#undef SEAM
}

extern "C" void kernel_launch(void* const* d_in, const int* in_sizes, int n_in, void* d_out, int out_size, void* d_ws, size_t ws_size, hipStream_t stream) {
    static int grid = 0;
    if (grid == 0) {
        if (n_in != 19 || (size_t)out_size != O_END || ws_size < WS_END) { fprintf(stderr, "kernel_launch: unexpected shapes: n_in %d out %d ws %zu; nothing launched\n", n_in, out_size, ws_size); grid = -1; return; }
        int dev = 0, cus = 0, per_cu = 0;
        if (hipGetDevice(&dev) != hipSuccess || hipDeviceGetAttribute(&cus, hipDeviceAttributeMultiprocessorCount, dev) != hipSuccess) { fprintf(stderr, "kernel_launch: device query failed\n"); grid = -1; return; }
        if (hipFuncSetAttribute((const void*)mega_fwd, hipFuncAttributeMaxDynamicSharedMemorySize, LDS_BYTES) != hipSuccess) { fprintf(stderr, "kernel_launch: hipFuncSetAttribute failed\n"); grid = -1; return; }
        if (hipOccupancyMaxActiveBlocksPerMultiprocessor(&per_cu, (const void*)mega_fwd, NTH, LDS_BYTES) != hipSuccess || per_cu < 1) fprintf(stderr, "kernel_launch: occupancy query reports %d workgroups per CU\n", per_cu);
        (void)hipGetLastError();
        grid = cus;
    }
    if (grid < 0) return;
    if (hipMemsetAsync((char*)d_ws + WS_CTL, 0, CTL_ZERO_BYTES, stream) != hipSuccess) { fprintf(stderr, "kernel_launch: memset failed\n"); return; }
    Params p{};
    for (int i = 0; i < 19; ++i) p.in[i] = (const float*)d_in[i];
    p.out = (float*)d_out; p.ws = (unsigned char*)d_ws;
#if MK_ONE_LAUNCH
    p.ph_lo = 0; p.ph_hi = N_PHASES;
    hipLaunchKernelGGL(mega_fwd, dim3(grid), dim3(NTH), LDS_BYTES, stream, p);
#else
    for (int ph = 0; ph < N_PHASES; ++ph) {
        if (ph >= 2 && ph < 22 && ((ph - 2) % 5) == 3 && (MK_NAIVE_ATT || !(((ph - 2) / 5) & 1))) continue;
        p.ph_lo = ph; p.ph_hi = ph + 1;
        hipLaunchKernelGGL(mega_fwd, dim3(grid), dim3(NTH), LDS_BYTES, stream, p);
    }
#endif
    const hipError_t le = hipPeekAtLastError();
    if (le != hipSuccess) fprintf(stderr, "kernel_launch: launch failed: %s\n", hipGetErrorName(le));
}
```

```cpp
#include <hip/hip_runtime.h>
#include <cstdio>
#include <cstdint>
#define GAS __attribute__((address_space(1)))
#define LAS __attribute__((address_space(3)))
namespace pg8 {
#define PG8_LAS __attribute__((address_space(3)))
typedef unsigned short bf16_t;
typedef short bf16x8 __attribute__((ext_vector_type(8)));
typedef float f32x4 __attribute__((ext_vector_type(4)));
typedef unsigned u32x4 __attribute__((ext_vector_type(4)));
constexpr int BM = 256, BK = 64, HALF = 128, HTB = HALF * BK * 2  , STAGE_BYTES = 8 * HTB, NXCD = 8, WGM = 4;

__host__ __device__ __forceinline__ int lds_byte(int r, int c) { const int st = (r >> 4) * 2 + (c >> 5), rr = r & 15, cc = c & 31, ob = rr * 64 + cc * 2; return st * 1024 + (ob ^ (((ob >> 9) & 1) << 5)); }
__host__ __device__ __forceinline__ void stage_rc(int b, int& R, int& C) { const int st = b / 1024, sb = b % 1024, swz = sb ^ (((sb >> 9) & 1) << 5); R = (st >> 1) * 16 + swz / 64; C = (st & 1) * 32 + (swz % 64) / 2; }
__host__ __device__ __forceinline__ int perm32(int rho) { const int n = rho >> 4, i = rho & 15; return 8 * (i >> 2) + 4 * n + (i & 3); }

struct Unit { int pm, pn; };
struct Gemm { const bf16_t* A; const bf16_t* Bt; int M, N, K, lda, agrp, ldb, bmode; };
__device__ __forceinline__ size_t gemm_boff(const Gemm& g, int pm) { return g.bmode ? ((size_t)(pm >> 4) * 2048 * 4096 + (size_t)((pm >> 2) & 3) * 1024) * 2 : (size_t)0; }

struct StaticOrder {
    int nM, nN, nwg, G, c;
    __host__ __device__ void init(int M, int N, int G_, int c_) { nM = M / BM; nN = N / BM; nwg = nM * nN; G = G_; c = c_; }
    __host__ __device__ bool next(int i, Unit& u) const {
        const long L = (long)i * G + c; if (L >= nwg) return false;
        int wgid = (int)L; { const int q = nwg / NXCD, r = nwg % NXCD, xcd = wgid % NXCD, off = wgid / NXCD; wgid = (xcd < r ? xcd * (q + 1) : r * (q + 1) + (xcd - r) * q) + off; }
        const int nig = WGM * nN, gid = wgid / nig, fm = gid * WGM, gsz = (nM - fm) < WGM ? (nM - fm) : WGM;
        u.pm = fm + ((wgid % nig) % gsz); u.pn = (wgid % nig) / gsz; return true;
    }
    __device__ __forceinline__ void a_ready(const Unit&) const {}
    __device__ __forceinline__ void done(const Unit&) const {}
};

__device__ __forceinline__ void glds16_sv(const char* sbase_in, unsigned voff, unsigned lds_dst_in) { unsigned keep;
    const unsigned long long b_ = (unsigned long long)sbase_in;
    const char* sbase = (const char*)(((unsigned long long)(unsigned)__builtin_amdgcn_readfirstlane((int)(b_ >> 32)) << 32) | (unsigned)__builtin_amdgcn_readfirstlane((int)(unsigned)b_));
    const unsigned lds_dst = (unsigned)__builtin_amdgcn_readfirstlane((int)lds_dst_in);
    asm volatile("s_mov_b32 %0, m0\n\ts_mov_b32 m0, %3\n\ts_nop 0\n\tglobal_load_lds_dwordx4 %1, %2\n\ts_mov_b32 m0, %0" : "=&s"(keep) : "v"(voff), "s"(sbase), "s"(lds_dst) : "memory"); }
template <class Epi, class Sched, bool ALIGN_EPI = false, bool SP2 = false>
__device__ __forceinline__ void gemm_phase(PG8_LAS unsigned char* lds, const Gemm g, const Sched& S, const Epi& E) {
    int tid = threadIdx.x; asm volatile("" : "+v"(tid));
    const int wid = __builtin_amdgcn_readfirstlane(tid >> 6), lane = tid & 63, wr = wid >> 2, wc = wid & 3, fr = lane & 15, fq = lane >> 4;
    const int K = g.K, nt = K / BK;
    unsigned voffA[2], voffB[2];
#pragma unroll
    for (int i = 0; i < 2; ++i) { int R, C; stage_rc(tid * 16 + i * 8192, R, C); const int Rb = Epi::PERM ? ((R & ~31) + perm32(R & 31)) : R;
        voffA[i] = (unsigned)(R * g.lda + C) * 2u; voffB[i] = (unsigned)(Rb * g.ldb + C) * 2u; }
    const size_t kstep = (size_t)(BK * 2);
    const size_t hstepB = (size_t)HALF * g.ldb * 2, hstepA = (size_t)HALF * g.lda * 2;
    const size_t tstepB = 2 * hstepB, tstepA = 2 * hstepA;
    const unsigned ldsw = (unsigned)wid * 1024u;
    const int aoff = lds_byte(wr * 64 + fr, fq * 8), boff = lds_byte(wc * 32 + fr, fq * 8);
#define PG8_SA(b, h) (((b) * 2 + (h)) * HTB)
#define PG8_SB(b, h) ((4 + (b) * 2 + (h)) * HTB)
#define PG8_STAGE(bufoff, gbase, voff) do { _Pragma("unroll") for (int _i = 0; _i < 2; ++_i) \
        glds16_sv((const char*)(gbase), (voff)[_i], (unsigned)(size_t)(lds + (bufoff) + ldsw + _i * 8192)); } while (0)
#define PG8_LDA(dst, b, h) do { _Pragma("unroll") for (int m = 0; m < 4; ++m) _Pragma("unroll") for (int k = 0; k < 2; ++k) dst[m][k] = *(const PG8_LAS bf16x8*)(lds + PG8_SA(b, h) + aoff + m * 2048 + k * 1024); } while (0)
#define PG8_LDB(dst, b, h) do { _Pragma("unroll") for (int n = 0; n < 2; ++n) _Pragma("unroll") for (int k = 0; k < 2; ++k) dst[n][k] = *(const PG8_LAS bf16x8*)(lds + PG8_SB(b, h) + boff + n * 2048 + k * 1024); } while (0)
#define PG8_MMA(ai, bj, At, Bt) do { __builtin_amdgcn_s_setprio(1); _Pragma("unroll") for (int m = 0; m < 4; ++m) _Pragma("unroll") for (int n = 0; n < 2; ++n) _Pragma("unroll") for (int k = 0; k < 2; ++k) \
        acc[ai][bj][m][n] = __builtin_amdgcn_mfma_f32_16x16x32_bf16(Bt[n][k], At[m][k], acc[ai][bj][m][n], 0, 0, 0); __builtin_amdgcn_s_setprio(0); } while (0)
#define PG8_WAIT_V(n) asm volatile("s_waitcnt vmcnt(" #n ")" ::: "memory")
#define PG8_WAIT_L(n) asm volatile("s_waitcnt lgkmcnt(" #n ")" ::: "memory")
#define PG8_BAR __builtin_amdgcn_s_barrier()
#define PG8_SCHED __builtin_amdgcn_sched_barrier(0)
    Unit cur, nxt; int ui = 0;
    if (!S.next(0, cur)) return;
    f32x4 acc[2][2][4][2];
#pragma unroll
    for (int a = 0; a < 2; ++a)
#pragma unroll
        for (int b = 0; b < 2; ++b)
#pragma unroll
            for (int m = 0; m < 4; ++m)
#pragma unroll
                for (int n = 0; n < 2; ++n) acc[a][b][m][n] = (f32x4){0.f, 0.f, 0.f, 0.f};
    bf16x8 At[4][2], B0[2][2], B1[2][2];
    const char* cA = (const char*)g.A + (size_t)cur.pm * tstepA + (g.agrp ? (size_t)(cur.pn / g.agrp) * K * 2 : (size_t)0); const char* cB = (const char*)g.Bt + (size_t)cur.pn * tstepB + gemm_boff(g, cur.pm);
    S.a_ready(cur);
    if constexpr (SP2) {
        PG8_STAGE(PG8_SB(0, 0), cB, voffB); PG8_STAGE(PG8_SB(0, 1), cB + hstepB, voffB); PG8_STAGE(PG8_SA(0, 0), cA, voffA); PG8_STAGE(PG8_SA(0, 1), cA + hstepA, voffA);
        if (wr == 1) PG8_BAR;
        PG8_WAIT_V(2); PG8_BAR;
        PG8_STAGE(PG8_SB(1, 0), cB + kstep, voffB); PG8_STAGE(PG8_SA(1, 0), cA + kstep, voffA); PG8_STAGE(PG8_SB(1, 1), cB + hstepB + kstep, voffB);
        PG8_WAIT_V(6); PG8_BAR;
    } else {
        PG8_STAGE(PG8_SB(0, 0), cB, voffB); PG8_STAGE(PG8_SA(0, 0), cA, voffA); PG8_STAGE(PG8_SB(0, 1), cB + hstepB, voffB); PG8_STAGE(PG8_SA(0, 1), cA + hstepA, voffA);
        if (wr == 1) PG8_BAR;
        PG8_WAIT_V(4); PG8_BAR;
        PG8_STAGE(PG8_SB(1, 0), cB + kstep, voffB); PG8_STAGE(PG8_SA(1, 0), cA + kstep, voffA); PG8_STAGE(PG8_SB(1, 1), cB + hstepB + kstep, voffB);
        PG8_WAIT_V(6); PG8_BAR;
    }
    for (;;) {
        const bool has_next = S.next(ui + 1, nxt);
        const char* nA = has_next ? (const char*)g.A + (size_t)nxt.pm * tstepA + (g.agrp ? (size_t)(nxt.pn / g.agrp) * K * 2 : (size_t)0) : cA; const char* nB = has_next ? (const char*)g.Bt + (size_t)nxt.pn * tstepB + gemm_boff(g, nxt.pm) : cB;
        for (int t = 0; t < nt; t += 2) {
            const bool last = (t == nt - 2);
            const char* a1 = cA + (size_t)(t + 1) * kstep;
            const char* a2 = last ? nA : cA + (size_t)(t + 2) * kstep; const char* b2 = last ? nB : cB + (size_t)(t + 2) * kstep;
            const char* a3 = a2 + kstep; const char* b3 = b2 + kstep;
            if (last && has_next) S.a_ready(nxt);
            if constexpr (SP2) {
            PG8_LDB(B0, 0, 0); PG8_LDB(B1, 0, 1); PG8_SCHED; PG8_LDA(At, 0, 0); PG8_STAGE(PG8_SA(1, 1), a1 + hstepA, voffA);
            PG8_WAIT_V(8); PG8_WAIT_L(0); PG8_BAR; PG8_MMA(0, 0, At, B0); PG8_MMA(0, 1, At, B1); PG8_BAR; PG8_SCHED;
            PG8_LDA(At, 0, 1); PG8_STAGE(PG8_SB(0, 0), b2, voffB); PG8_STAGE(PG8_SB(0, 1), b2 + hstepB, voffB); PG8_STAGE(PG8_SA(0, 0), a2, voffA);
            PG8_WAIT_V(8); PG8_WAIT_L(0); PG8_BAR; PG8_MMA(1, 0, At, B0); PG8_MMA(1, 1, At, B1); PG8_BAR; PG8_SCHED;
            PG8_LDB(B0, 1, 0); PG8_LDB(B1, 1, 1); PG8_SCHED; PG8_LDA(At, 1, 0); PG8_STAGE(PG8_SA(0, 1), a2 + hstepA, voffA);
            PG8_WAIT_V(8); PG8_WAIT_L(0); PG8_BAR; PG8_MMA(0, 0, At, B0); PG8_MMA(0, 1, At, B1); PG8_BAR; PG8_SCHED;
            PG8_LDA(At, 1, 1); PG8_STAGE(PG8_SB(1, 0), b3, voffB); PG8_STAGE(PG8_SB(1, 1), b3 + hstepB, voffB); PG8_STAGE(PG8_SA(1, 0), a3, voffA);
            PG8_WAIT_V(8); PG8_WAIT_L(0); PG8_BAR; PG8_MMA(1, 0, At, B0); PG8_MMA(1, 1, At, B1); PG8_BAR; PG8_SCHED;
            } else {
            PG8_LDB(B0, 0, 0); PG8_SCHED; PG8_LDA(At, 0, 0); PG8_STAGE(PG8_SA(1, 1), a1 + hstepA, voffA);
            PG8_WAIT_L(8); PG8_BAR; PG8_WAIT_L(0); PG8_MMA(0, 0, At, B0); PG8_BAR; PG8_SCHED;
            PG8_LDB(B1, 0, 1); PG8_STAGE(PG8_SB(0, 0), b2, voffB);
            PG8_BAR; PG8_WAIT_L(0); PG8_MMA(0, 1, At, B1); PG8_BAR;
            PG8_LDA(At, 0, 1); PG8_STAGE(PG8_SA(0, 0), a2, voffA);
            PG8_BAR; PG8_WAIT_L(0); PG8_MMA(1, 0, At, B0); PG8_BAR; PG8_SCHED;
            PG8_STAGE(PG8_SB(0, 1), b2 + hstepB, voffB);
            PG8_WAIT_V(6); PG8_BAR; PG8_MMA(1, 1, At, B1); PG8_BAR;
            PG8_LDB(B0, 1, 0); PG8_SCHED; PG8_LDA(At, 1, 0); PG8_STAGE(PG8_SA(0, 1), a2 + hstepA, voffA);
            PG8_WAIT_L(8); PG8_BAR; PG8_WAIT_L(0); PG8_MMA(0, 0, At, B0); PG8_BAR; PG8_SCHED;
            PG8_LDB(B1, 1, 1); PG8_STAGE(PG8_SB(1, 0), b3, voffB);
            PG8_BAR; PG8_WAIT_L(0); PG8_MMA(0, 1, At, B1); PG8_BAR;
            PG8_LDA(At, 1, 1); PG8_STAGE(PG8_SA(1, 0), a3, voffA);
            PG8_BAR; PG8_WAIT_L(0); PG8_MMA(1, 0, At, B0); PG8_BAR; PG8_SCHED;
            PG8_STAGE(PG8_SB(1, 1), b3 + hstepB, voffB);
            PG8_WAIT_V(6); PG8_BAR; PG8_MMA(1, 1, At, B1); PG8_BAR;
            }
        }
        if constexpr (ALIGN_EPI) { if (wr == 0) PG8_BAR; }
        if constexpr (!Epi::AFTER_DRAIN) { E(acc, cur, wr, wc, fr, fq); S.done(cur); }
        if (!has_next) break;
#pragma unroll
        for (int a = 0; a < 2; ++a)
#pragma unroll
            for (int b = 0; b < 2; ++b)
#pragma unroll
                for (int m = 0; m < 4; ++m)
#pragma unroll
                    for (int n = 0; n < 2; ++n) acc[a][b][m][n] = (f32x4){0.f, 0.f, 0.f, 0.f};
        cur = nxt; cA = nA; cB = nB; ++ui;
        if constexpr (ALIGN_EPI) { if (wr == 1) PG8_BAR; }
    }
    PG8_WAIT_V(0);
    if constexpr (!ALIGN_EPI) { if (wr == 0) PG8_BAR; }
    PG8_BAR;
    if constexpr (Epi::AFTER_DRAIN) { E.fused(acc, cur, wr, wc, fr, fq, lds, wid, lane); S.done(cur); }
#undef PG8_SA
#undef PG8_SB
#undef PG8_STAGE
#undef PG8_LDA
#undef PG8_LDB
#undef PG8_MMA
#undef PG8_WAIT_V
#undef PG8_WAIT_L
#undef PG8_BAR
#undef PG8_SCHED
}
}

#define XB_TMO      128
#define XB_XCNT(j)  (256  + 64 * (j))
#define XB_XSUB(j)  (1280 + 64 * (j))
#define XB_XGEN(j)  (2304 + 64 * (j))
#define XB_TOP      3328
#define XB_TOPGEN   3392
#define XCD_BAR_WORDS 3456
#define XB_SPIN_CAP (1u << 18)

__device__ __forceinline__ unsigned xb_ld(unsigned* p)              { return __hip_atomic_load(p, __ATOMIC_RELAXED, __HIP_MEMORY_SCOPE_AGENT); }
__device__ __forceinline__ unsigned xb_add(unsigned* p, unsigned v) { return __hip_atomic_fetch_add(p, v, __ATOMIC_RELAXED, __HIP_MEMORY_SCOPE_AGENT); }
__device__ __forceinline__ unsigned xb_xcc_id() { return (unsigned)__builtin_amdgcn_s_getreg((3 << 11) | 20) & 0xFu; }
#define XB_SPIN(cond, bar) do { unsigned _sp = 0; while (cond) { __builtin_amdgcn_s_sleep(1); \
    if ((++_sp & 255u) == 0u) { if (xb_ld(&(bar)[XB_TMO])) break; if (_sp > XB_SPIN_CAP) { atomicAdd(&(bar)[XB_TMO], 1u); break; } } } } while (0)

struct XcdBarrier {
    unsigned* bar; unsigned x;
    volatile LAS unsigned* st;
};

__device__ __forceinline__ XcdBarrier xcd_barrier_post(unsigned* bar, volatile LAS unsigned* st) {
    XcdBarrier b; b.bar = bar; b.x = xb_xcc_id(); b.st = st;
    if (threadIdx.x == 0) (void)xb_add(&bar[XB_XCNT(b.x)], 1u);
    return b;
}
__device__ __forceinline__ void xcd_barrier_complete(unsigned* bar, unsigned x, unsigned& nloc, unsigned& nx) {
    const unsigned G = gridDim.x * gridDim.y * gridDim.z;
    unsigned sum, cnt, mine, sp = 0u;
    for (;;) {
        sum = 0u; cnt = 0u; mine = 0u;
#pragma unroll
        for (unsigned j = 0; j < 16; ++j) { const unsigned c = xb_ld(&bar[XB_XCNT(j)]); sum += c; cnt += (c > 0u) ? 1u : 0u; mine = (j == x) ? c : mine; }
        if (sum == G) break;
        __builtin_amdgcn_s_sleep(1);
        if ((++sp & 255u) == 0u) { if (xb_ld(&bar[XB_TMO])) break; if (sp > XB_SPIN_CAP) { atomicAdd(&bar[XB_TMO], 1u); break; } }
    }
    nloc = mine > 0u ? mine : 1u; nx = cnt > 0u ? cnt : 1u;
}

__device__ __forceinline__ void xcd_barrier(const XcdBarrier& b) {
    asm volatile("s_waitcnt vmcnt(0)" ::: "memory");
    __syncthreads();
    if (threadIdx.x == 0) {
        unsigned* bar = b.bar;
        __builtin_amdgcn_s_waitcnt(0);
        unsigned nloc = b.st[0], nx = b.st[1];
        if (nloc == 0u) { xcd_barrier_complete(bar, b.x, nloc, nx); b.st[0] = nloc; b.st[1] = nx; }
        const unsigned old = xb_add(&bar[XB_XSUB(b.x)], 1u);
        const unsigned gen = old / nloc;
        if (old + 1u == (gen + 1u) * nloc) {
            __builtin_amdgcn_fence(__ATOMIC_RELEASE, "agent");
            asm volatile("s_waitcnt vmcnt(0)" ::: "memory");
            const unsigned og = xb_add(&bar[XB_TOP], 1u);
            const unsigned tg = og / nx;
            if (og + 1u == (tg + 1u) * nx) xb_add(&bar[XB_TOPGEN], 1u);
            else XB_SPIN(xb_ld(&bar[XB_TOPGEN]) == tg, bar);
            __builtin_amdgcn_fence(__ATOMIC_ACQUIRE, "agent");
            xb_add(&bar[XB_XGEN(b.x)], 1u);
            asm volatile("s_waitcnt vmcnt(0)" ::: "memory");
        } else {
            XB_SPIN(xb_ld(&bar[XB_XGEN(b.x)]) == gen, bar);
            __builtin_amdgcn_fence(__ATOMIC_ACQUIRE, "agent");
            asm volatile("s_waitcnt vmcnt(0)" ::: "memory");
        }
    }
    __syncthreads();
}

#ifndef MK_NAIVE_GEMM
#define MK_NAIVE_GEMM 0
#endif
#ifndef MK_NAIVE_ATT
#define MK_NAIVE_ATT 0
#endif
#ifndef MK_REP_KIND
#define MK_REP_KIND -1
#endif
#ifndef MK_REP_N
#define MK_REP_N 2
#endif
#define REPS(kind) for (int rep_ = 0; rep_ < ((MK_REP_KIND == (kind)) ? 1 + MK_REP_N : 1); ++rep_)
#ifndef MK_STAGGER
#define MK_STAGGER 0
#endif
#ifndef MK_DOUBLE_STORE
#define MK_DOUBLE_STORE 0
#endif
#ifndef MK_TPROBE
#define MK_TPROBE 0
#endif
#ifndef MK_TBLOCK
#define MK_TBLOCK 0
#endif
#ifndef MK_TCAT_A
#define MK_TCAT_A 0
#endif
#ifndef MK_TCAT_B
#define MK_TCAT_B 1
#endif
#ifndef MK_ONE_LAUNCH
#define MK_ONE_LAUNCH 1
#endif

constexpr int D = 2048, NB = 4, SEQ = 2048, MROWS = NB * SEQ, NS = 8;
constexpr int PW = 4096, PIN = 8192, QKVW = 6144, AIN = 20480;
constexpr int NWAVES = 8, NTH = 512;
constexpr float RMS_EPS = 1e-6f, ATT_SCALE = 0.08838834764831845f, NEG_INF = -1e30f;
constexpr size_t O_YP = 0, O_YS = O_YP + (size_t)MROWS * D, O_KV0P = O_YS + (size_t)NS * D, O_KV1P = O_KV0P + (size_t)2 * 4 * 128 * 4096, O_KV2P = O_KV1P + (size_t)2 * 4 * 512 * 4096,
                 O_POOLP = O_KV2P + (size_t)2 * 4 * 2048 * 4096, O_KV0S = O_POOLP + (size_t)2 * 4 * 15 * 4096, O_KV1S = O_KV0S + 2 * 8 * 4096, O_KV2S = O_KV1S + 2 * 8 * 4096,
                 O_POOLS = O_KV2S + 2 * 8 * 4096, O_END = O_POOLS + (size_t)2 * 8 * 15 * 4096;
static_assert(O_END == 106545152, "output size");
constexpr size_t MiB = 1u << 20;
constexpr size_t WS_CTL = 0, CTL_ZERO_BYTES = 64 * 1024;
constexpr size_t WS_MOD = 1 * MiB;
constexpr size_t WS_BIAS = 3 * MiB;
constexpr size_t WS_PS = 4 * MiB;
constexpr size_t WS_RS = 5 * MiB;
constexpr size_t WS_A3S = 6 * MiB;
constexpr size_t WS_OGS = 7 * MiB;
constexpr size_t WS_LSES = 7 * MiB + 896 * 1024;
constexpr size_t WS_WG1 = 8 * MiB;
constexpr size_t WS_WPG = 72 * MiB;
constexpr size_t WS_WPO = 88 * MiB;
constexpr size_t WS_WAI = 120 * MiB;
constexpr size_t WS_WAO = 280 * MiB;
constexpr size_t WS_H = 296 * MiB;
constexpr size_t WS_PROJ = 330 * MiB;
constexpr size_t WS_WUN = 650 * MiB;
constexpr size_t WS_WUT = 682 * MiB;
constexpr size_t WS_A3 = 714 * MiB;
constexpr size_t WS_Y = 778 * MiB;
constexpr size_t WS_OG = 844 * MiB;
constexpr size_t WS_LSE = 940 * MiB;
constexpr size_t WS_END = 942 * MiB;
constexpr int CW_BAR = 4096;
constexpr int RING_BYTES = 131072, LDSCTL_OFF = RING_BYTES, MISC_OFF = LDSCTL_OFF + 320, LDS_BYTES = 147456;
constexpr int N_PHASES = 23;

typedef unsigned short bf16;
typedef short bf16x8 __attribute__((ext_vector_type(8)));
typedef float f32x4 __attribute__((ext_vector_type(4)));
typedef float f32x2 __attribute__((ext_vector_type(2)));
typedef unsigned u32x4 __attribute__((ext_vector_type(4)));
typedef unsigned u32x2 __attribute__((ext_vector_type(2)));

__device__ __forceinline__ unsigned f2bf(float f) { unsigned u = __builtin_bit_cast(unsigned, f); return (u + 0x7fffu + ((u >> 16) & 1u)) >> 16; }
__device__ __forceinline__ unsigned pk2(float lo, float hi) { return f2bf(lo) | (f2bf(hi) << 16); }
__device__ __forceinline__ float bflo(unsigned w) { return __builtin_bit_cast(float, w << 16); }
__device__ __forceinline__ float bfhi(unsigned w) { return __builtin_bit_cast(float, w & 0xffff0000u); }
__device__ __forceinline__ float silu_f(float x) { return x / (1.0f + __expf(-x)); }
__device__ __forceinline__ float wave_sum(float v) {
#pragma unroll
    for (int o = 1; o < 64; o <<= 1) v += __shfl_xor(v, o);
    return v;
}
__device__ __forceinline__ float wave_max(float v) {
#pragma unroll
    for (int o = 1; o < 64; o <<= 1) v = fmaxf(v, __shfl_xor(v, o));
    return v;
}
__device__ __forceinline__ unsigned cvt_pk_bf16(float lo, float hi) { unsigned r; asm volatile("v_cvt_pk_bf16_f32 %0, %1, %2" : "=v"(r) : "v"(lo), "v"(hi)); return r; }
__device__ __forceinline__ u32x4 pack8(const f32x4 a, const f32x4 b) { u32x4 w; w.x = cvt_pk_bf16(a.x, a.y); w.y = cvt_pk_bf16(a.z, a.w); w.z = cvt_pk_bf16(b.x, b.y); w.w = cvt_pk_bf16(b.z, b.w); return w; }
__device__ __forceinline__ float dot8(const u32x4 a, const u32x4 b) {
    return (bflo(a.x) * bflo(b.x) + bfhi(a.x) * bfhi(b.x)) + (bflo(a.y) * bflo(b.y) + bfhi(a.y) * bfhi(b.y)) + (bflo(a.z) * bflo(b.z) + bfhi(a.z) * bfhi(b.z)) + (bflo(a.w) * bflo(b.w) + bfhi(a.w) * bfhi(b.w));
}

struct Params { const float* in[19]; float* out; unsigned char* ws; int ph_lo, ph_hi; };
struct Ctx { LAS unsigned char* lds; int tid, lane, wave, vcu, G, gw, NGW; };

template <class S8> struct Epi8 {
    static constexpr bool PERM = true, AFTER_DRAIN = false;
    S8 s;
    __device__ __forceinline__ void operator()(const pg8::f32x4 (&acc)[2][2][4][2], const pg8::Unit& u, int wr, int wc, int fr, int fq) const {
        asm volatile("" : "+v"(fr), "+v"(fq));
        const int row0 = u.pm * 256 + wr * 64 + fr, col0 = u.pn * 256 + wc * 32 + 8 * fq;
#pragma unroll
        for (int ai = 0; ai < 2; ++ai)
#pragma unroll
            for (int m = 0; m < 4; ++m)
#pragma unroll
                for (int bj = 0; bj < 2; ++bj) { s.store8(row0 + ai * 128 + m * 16, col0 + bj * 128, acc[ai][bj][m][0], acc[ai][bj][m][1]);
#if MK_DOUBLE_STORE
                    asm volatile("" ::: "memory"); s.store8(row0 + ai * 128 + m * 16, col0 + bj * 128, acc[ai][bj][m][0], acc[ai][bj][m][1]);
#endif
                }
    }
};
struct StWg1 {
    bf16* wg1;
    __device__ __forceinline__ void store8(int row, int col, const f32x4 v0, const f32x4 v1) const { *(u32x4*)(wg1 + ((size_t)(row >> 12) * PIN + (row & 4095)) * D + col) = pack8(v0, v1); }
};
struct StG2p {
    const bf16* proj; const float* scale; bf16* a3;
    __device__ __forceinline__ void store8(int row, int col, const f32x4 v0, const f32x4 v1) const {
        const u32x4 z = *(const u32x4*)(proj + (size_t)row * PIN + PW + col);
        const f32x4 s0 = *(const f32x4*)(scale + col), s1 = *(const f32x4*)(scale + col + 4);
        f32x4 a, b;
        a.x = v0.x * s0.x * silu_f(bflo(z.x)); a.y = v0.y * s0.y * silu_f(bfhi(z.x)); a.z = v0.z * s0.z * silu_f(bflo(z.y)); a.w = v0.w * s0.w * silu_f(bfhi(z.y));
        b.x = v1.x * s1.x * silu_f(bflo(z.z)); b.y = v1.y * s1.y * silu_f(bfhi(z.z)); b.z = v1.z * s1.z * silu_f(bflo(z.w)); b.w = v1.w * s1.w * silu_f(bfhi(z.w));
        *(u32x4*)(a3 + (size_t)row * PW + col) = pack8(a, b);
    }
};
struct StF32 {
    float* C; int ldc;
    __device__ __forceinline__ void store8(int row, int col, const f32x4 v0, const f32x4 v1) const { float* o = C + (size_t)row * ldc + col; *(f32x4*)o = v0; *(f32x4*)(o + 4) = v1; }
};
struct StBf16 {
    bf16* C; int ldc;
    __device__ __forceinline__ void store8(int row, int col, const f32x4 v0, const f32x4 v1) const { *(u32x4*)(C + (size_t)row * ldc + col) = pack8(v0, v1); }
};
struct StG1a {
    bf16* proj; float* out; int li;
    __device__ __forceinline__ void store8(int row, int col, const f32x4 v0, const f32x4 v1) const {
        *(u32x4*)(proj + (size_t)row * AIN + col) = pack8(v0, v1);
        if (col >= QKVW && col < 3 * QKVW) {
            int cc = col - QKVW; const int kv = cc >= QKVW ? 1 : 0; cc -= kv * QKVW; const int g = cc >> 11, he = cc & 2047, keep = 128 << (2 * g), t = row & (SEQ - 1), b = row >> 11;
            if (t >= SEQ - keep) {
                const size_t base = g == 0 ? O_KV0P : (g == 1 ? O_KV1P : O_KV2P);
                float* o = out + base + ((size_t)((li * 4 + b) * keep + (t - (SEQ - keep)))) * 4096 + kv * 2048 + he; *(f32x4*)o = v0; *(f32x4*)(o + 4) = v1;
            }
        }
    }
};

template <class S8> __device__ __forceinline__ void naive_gemm(const pg8::Gemm g, const S8& st, int gtid, int nth) {
    const int n8 = g.N / 8; const long total = (long)g.M * n8;
    for (long task = gtid; task < total; task += nth) {
        const int row = (int)(task % g.M), col = (int)(task / g.M) * 8;
        const bf16* a = g.A + (size_t)row * g.lda + (g.agrp ? (size_t)(col / (256 * g.agrp)) * g.K : (size_t)0);
        const bf16* b = g.Bt + (size_t)col * g.ldb + gemm_boff(g, row >> 8) / 2;
        float acc[8];
#pragma unroll
        for (int c = 0; c < 8; ++c) acc[c] = 0.f;
        for (int k = 0; k < g.K; k += 8) {
            const u32x4 av = *(const u32x4*)(a + k);
#pragma unroll
            for (int c = 0; c < 8; ++c) acc[c] += dot8(av, *(const u32x4*)(b + (size_t)c * g.ldb + k));
        }
        st.store8(row, col, (f32x4){acc[0], acc[1], acc[2], acc[3]}, (f32x4){acc[4], acc[5], acc[6], acc[7]});
    }
}
#ifndef MK_FAST_MASK
#define MK_FAST_MASK 31
#endif
template <int SITE, class S8> __device__ __forceinline__ void run_gemm(const Ctx& c, const pg8::Gemm g, const S8& st) {
    if constexpr (MK_NAIVE_GEMM || !((MK_FAST_MASK >> SITE) & 1)) naive_gemm(g, st, (int)blockIdx.x * NTH + c.tid, c.G * NTH);
    else {
        pg8::StaticOrder S; S.init(g.M, g.N, c.G, (int)blockIdx.x);
        Epi8<S8> E{st};
#if MK_STAGGER
        if (SITE == 0 || SITE == 3) {
            const unsigned long long t0 = __builtin_amdgcn_s_memrealtime(); const unsigned long long wt = (unsigned long long)(((blockIdx.x >> 3) & 7) * MK_STAGGER);
            while (__builtin_amdgcn_s_memrealtime() - t0 < wt) __builtin_amdgcn_s_sleep(8);
        }
#endif
        pg8::gemm_phase<Epi8<S8>, pg8::StaticOrder, true, true>((PG8_LAS unsigned char*)c.lds, g, S, E);
    }
}

template <int NCG, int KS, class F> __device__ __forceinline__ void sgemm8(const Ctx& c, const bf16* As, int lda, int agrp_cols, const bf16* Wt, int N, int K, const F& epi) {
    const int q = c.lane >> 4, r = c.lane & 15, kbeg = c.wave * (KS * 32), pitch = (lda + 8) * 2, cpr = lda >> 3;
    for (int ch = c.tid; ch < lda; ch += NTH) { const int row = ch / cpr, cc = ch - row * cpr; *(LAS u32x4*)(c.lds + row * pitch + cc * 16) = *(const u32x4*)(As + (size_t)row * lda + cc * 8); }
    bf16x8 wf[NCG][KS];
#pragma unroll
    for (int s = 0; s < NCG; ++s) { const int cg = c.vcu + s * c.G, cgc = cg < N / 16 ? cg : 0; const bf16* wrow = Wt + (size_t)(cgc * 16 + r) * K + kbeg + q * 8;
#pragma unroll
        for (int k = 0; k < KS; ++k) wf[s][k] = *(const bf16x8*)(wrow + k * 32); }
    __syncthreads();
    LAS float* red = (LAS float*)(c.lds + 73728);
#pragma unroll
    for (int s = 0; s < NCG; ++s) { const int cg = c.vcu + s * c.G;
        if (cg < N / 16) {
            const int acol = (agrp_cols ? ((cg * 16) / agrp_cols) * K : 0) + kbeg + q * 8;
            pg8::f32x4 acc = {0.f, 0.f, 0.f, 0.f};
#pragma unroll
            for (int k = 0; k < KS; ++k) { bf16x8 a = *(const LAS bf16x8*)(c.lds + (r & 7) * pitch + (acol + k * 32) * 2); if (r >= 8) a = (bf16x8){0, 0, 0, 0, 0, 0, 0, 0};
                acc = __builtin_amdgcn_mfma_f32_16x16x32_bf16(a, wf[s][k], acc, 0, 0, 0); }
            if (q < 2) {
#pragma unroll
                for (int j = 0; j < 4; ++j) red[(s * 8 + c.wave) * 128 + (q * 4 + j) * 16 + r] = acc[j]; }
        } }
    __syncthreads();
    for (int o = c.tid; o < NCG * 128; o += NTH) {
        const int sl = o >> 7, sr = (o >> 4) & 7, nn = o & 15, cg = c.vcu + sl * c.G;
        if (cg < N / 16) { float sum = 0.f;
#pragma unroll
            for (int w = 0; w < 8; ++w) sum += red[(sl * 8 + w) * 128 + sr * 16 + nn];
            epi(sr, cg * 16 + nn, sum); }
    }
    __syncthreads();
}

__device__ __forceinline__ void ulast_gemm(const Ctx& c, const bf16* Hrows, const bf16* Wut, float* outpool) {
    const int q = c.lane >> 4, r = c.lane & 15, kbeg = c.wave * 256, rr = r < 15 ? r : 14;
    LAS float* red = (LAS float*)c.lds;
    int nslots = 0;
    for (int cg = c.vcu; cg < PW / 16; cg += c.G, ++nslots) {
        const bf16* wrow = Wut + (size_t)(cg * 16 + r) * D + kbeg + q * 8;
        const bf16* arow = Hrows + (size_t)(SEQ - 15 + rr) * D + kbeg + q * 8;
        pg8::f32x4 acc[4];
#pragma unroll
        for (int bb = 0; bb < 4; ++bb) acc[bb] = (pg8::f32x4){0.f, 0.f, 0.f, 0.f};
#pragma unroll 2
        for (int k0 = 0; k0 < 256; k0 += 32) {
            const bf16x8 b = *(const bf16x8*)(wrow + k0);
#pragma unroll
            for (int bb = 0; bb < 4; ++bb) { const bf16x8 a = *(const bf16x8*)(arow + (size_t)bb * SEQ * D + k0); acc[bb] = __builtin_amdgcn_mfma_f32_16x16x32_bf16(a, b, acc[bb], 0, 0, 0); }
        }
#pragma unroll
        for (int bb = 0; bb < 4; ++bb)
#pragma unroll
            for (int j = 0; j < 4; ++j) red[((nslots * 8 + c.wave) * 4 + bb) * 256 + (q * 4 + j) * 16 + r] = acc[bb][j];
    }
    __syncthreads();
    for (int o = c.tid; o < nslots * 1024; o += NTH) {
        const int sl = o >> 10, bb = (o >> 8) & 3, row = (o >> 4) & 15, nn = o & 15; float sum = 0.f;
#pragma unroll
        for (int w = 0; w < 8; ++w) sum += red[((sl * 8 + w) * 4 + bb) * 256 + row * 16 + nn];
        if (row < 15) outpool[((size_t)(bb * 15 + row)) * PW + (c.vcu + sl * c.G) * 16 + nn] = sum;
    }
    __syncthreads();
}

__device__ __forceinline__ void p0_transpose_item(const float* W, int K, int N, bf16* WT, int row_off, LAS float* scr, int item, int lane, bf16* WN = nullptr, int ldn = 0) {
    const int nblk = N / 32, kb = item / nblk, nb = item % nblk, k0 = 64 * kb, n0 = 32 * nb;
    float wv[32];
#pragma unroll
    for (int i = 0; i < 32; ++i) wv[i] = W[(size_t)(k0 + 2 * i + (lane >> 5)) * N + n0 + (lane & 31)];
#pragma unroll
    for (int i = 0; i < 32; ++i) scr[(2 * i + (lane >> 5)) * 33 + (lane & 31)] = wv[i];
    asm volatile("s_waitcnt lgkmcnt(0)" ::: "memory");
    const int cch = lane & 7;
#pragma unroll
    for (int j = 0; j < 4; ++j) { const int n = (lane >> 3) + 8 * j; const LAS float* s = scr + (8 * cch) * 33 + n;
        u32x4 o; o.x = pk2(s[0 * 33], s[1 * 33]); o.y = pk2(s[2 * 33], s[3 * 33]); o.z = pk2(s[4 * 33], s[5 * 33]); o.w = pk2(s[6 * 33], s[7 * 33]);
        *(u32x4*)(WT + (size_t)(row_off + n0 + n) * K + k0 + 8 * cch) = o; }
    if (WN) {
        const LAS float* sr = scr + lane * 33; bf16* wn = WN + (size_t)(k0 + lane) * ldn + n0;
#pragma unroll
        for (int j = 0; j < 4; ++j) { u32x4 o; o.x = pk2(sr[8 * j + 0], sr[8 * j + 1]); o.y = pk2(sr[8 * j + 2], sr[8 * j + 3]); o.z = pk2(sr[8 * j + 4], sr[8 * j + 5]); o.w = pk2(sr[8 * j + 6], sr[8 * j + 7]); *(u32x4*)(wn + 8 * j) = o; }
    }
    asm volatile("s_waitcnt lgkmcnt(0)" ::: "memory");
}
__device__ __forceinline__ void adaln_unit(const Params& p, const Ctx& c, int unit) {
    const int i = unit / 48, n0 = (unit % 48) * 128;
    LAS float* S = (LAS float*)c.lds;
    for (int idx = c.tid; idx < 12 * D; idx += NTH) { const int r = idx >> 11, k = idx & (D - 1); const float cv = r < 4 ? p.in[2][r * D + k] : p.in[3][(r - 4) * D + k]; S[idx] = silu_f(cv); }
    __syncthreads();
    float acc[12][2];
#pragma unroll
    for (int r = 0; r < 12; ++r) { acc[r][0] = 0.f; acc[r][1] = 0.f; }
    const int kb = c.wave * 256;
    const float* W = p.in[10] + ((size_t)i * D + kb) * 6144 + n0 + 2 * c.lane;
    for (int k = 0; k < 256; k += 4) {
        f32x2 w[4];
#pragma unroll
        for (int u = 0; u < 4; ++u) w[u] = *(const f32x2*)(W + (size_t)(k + u) * 6144);
#pragma unroll
        for (int r = 0; r < 12; ++r) { const f32x4 s = *(const LAS f32x4*)(S + r * D + kb + k);
            acc[r][0] += (s.x * w[0].x + s.y * w[1].x) + (s.z * w[2].x + s.w * w[3].x); acc[r][1] += (s.x * w[0].y + s.y * w[1].y) + (s.z * w[2].y + s.w * w[3].y); }
    }
    __syncthreads();
    LAS float* P = (LAS float*)c.lds;
#pragma unroll
    for (int r = 0; r < 12; ++r) { P[(c.wave * 12 + r) * 128 + 2 * c.lane] = acc[r][0]; P[(c.wave * 12 + r) * 128 + 2 * c.lane + 1] = acc[r][1]; }
    __syncthreads();
    float* MOD = (float*)(p.ws + WS_MOD);
    for (int o = c.tid; o < 12 * 128; o += NTH) { const int r = o >> 7, n = o & 127; float s = 0.f;
#pragma unroll
        for (int w = 0; w < 8; ++w) s += P[(w * 12 + r) * 128 + n];
        MOD[(size_t)(i * 12 + r) * 6144 + n0 + n] = s + p.in[11][i * 6144 + n0 + n]; }
    __syncthreads();
}
__device__ __forceinline__ void phase_prologue(const Params& p, const Ctx& c) {
    for (int unit = c.vcu; unit < 192; unit += c.G) adaln_unit(p, c, unit);
    if (c.vcu == c.G - 1) {
        float* BIAS = (float*)(p.ws + WS_BIAS);
        for (int idx = c.tid; idx < 48 * 129; idx += NTH) { const int sh = idx / 129, j = idx % 129, g = sh >> 4, dist = j << (2 * g); int bucket;
            if (dist < 16) bucket = dist; else { const int large = 16 + (int)(log((double)dist / 16.0) / log(128.0) * 16.0); bucket = large < 31 ? large : 31; }
            BIAS[sh * 132 + j] = p.in[12][bucket * 48 + sh]; }
    }
    LAS float* scr = (LAS float*)(c.lds + c.wave * 16384);
    constexpr int I_PI = 32 * 256, I_PG = 16 * 32, I_PO = 64 * 64, I_AI = 32 * 640, I_AO = 32 * 64, I_LAYER = I_PI + 4 * I_PG + I_PO + I_AI + I_AO;
    for (int it = c.gw; it < 2 * I_LAYER; it += c.NGW) {
        const int li = it / I_LAYER; int r = it % I_LAYER;
        if (r < I_PI) {
            const bool isu = (r % 256) < 128;
            if (isu) p0_transpose_item(p.in[13] + (size_t)li * D * PIN, D, PIN, (bf16*)(p.ws + WS_WUT) + (size_t)li * PW * D, 0, scr, r, c.lane, (bf16*)(p.ws + WS_WUN) + (size_t)li * D * PW, PW);
            else p0_transpose_item(p.in[13] + (size_t)li * D * PIN, D, PIN, (bf16*)(p.ws + WS_WG1) + (size_t)li * PIN * D, 0, scr, r, c.lane);
            continue; } r -= I_PI;
        if (r < 4 * I_PG) { const int g = r / I_PG; p0_transpose_item(p.in[14] + (size_t)(li * 4 + g) * 1024 * 1024, 1024, 1024, (bf16*)(p.ws + WS_WPG) + (size_t)li * PW * 1024, g * 1024, scr, r % I_PG, c.lane); continue; } r -= 4 * I_PG;
        if (r < I_PO) { p0_transpose_item(p.in[16] + (size_t)li * PW * D, PW, D, (bf16*)(p.ws + WS_WPO) + (size_t)li * D * PW, 0, scr, r, c.lane); continue; } r -= I_PO;
        if (r < I_AI) { p0_transpose_item(p.in[17] + (size_t)li * D * AIN, D, AIN, (bf16*)(p.ws + WS_WAI) + (size_t)li * AIN * D, 0, scr, r, c.lane); continue; } r -= I_AI;
        p0_transpose_item(p.in[18] + (size_t)li * D * D, D, D, (bf16*)(p.ws + WS_WAO) + (size_t)li * D * D, 0, scr, r, c.lane);
    }
}

struct NormRow { const float* xi; float* xo; const void* y; bf16* h; int mr; bool smp; };
__device__ __forceinline__ NormRow norm_row_of(const Params& p, int i, int r) {
    NormRow R; R.smp = r >= MROWS; const int b = R.smp ? r - MROWS : r >> 11; R.mr = R.smp ? 4 + b : b;
    R.xo = R.smp ? p.out + O_YS + (size_t)b * D : p.out + O_YP + (size_t)r * D;
    const float* const xin0 = p.in[0]; const float* const xin1 = p.in[1];
    R.xi = (i <= 1) ? (R.smp ? xin1 + (size_t)b * D : xin0 + (size_t)r * D) : R.xo;
    R.y = R.smp ? (const void*)((const float*)(p.ws + WS_Y) + (size_t)r * D) : (const void*)((const bf16*)(p.ws + WS_Y) + (size_t)r * D);
    R.h = (bf16*)(p.ws + WS_H) + (size_t)r * D; return R;
}
__device__ __forceinline__ void norm_dma_row(const Ctx& c, LAS unsigned char* slot, const NormRow& R, bool with_y) {
#pragma unroll
    for (int j = 0; j < 8; ++j) __builtin_amdgcn_global_load_lds((const unsigned*)(R.xi + (size_t)(j * 64 + c.lane) * 4), (LAS unsigned*)(slot + j * 1024), 16, 0, 0);
    if (with_y) {
#pragma unroll
        for (int j = 0; j < 8; ++j) if (j < 4 || R.smp) __builtin_amdgcn_global_load_lds((const unsigned*)((const char*)R.y + (size_t)(j * 64 + c.lane) * 16), (LAS unsigned*)(slot + 8192 + j * 1024), 16, 0, 0);
    }
}
__device__ __forceinline__ void phase_norm(const Params& p, const Ctx& c, int i) {
    const float* MOD = (const float*)(p.ws + WS_MOD);
    LAS unsigned char* slot = c.lds + c.wave * 16384;
    int row = c.gw;
    if (row < MROWS + NS) { const NormRow R0 = norm_row_of(p, i, row); norm_dma_row(c, slot, R0, i > 0); }
    for (; row < MROWS + NS; row += c.NGW) {
        const NormRow R = norm_row_of(p, i, row);
        if (row == c.gw) asm volatile("s_waitcnt vmcnt(0)" ::: "memory");
        else if (i > 0 && i < 4) asm volatile("s_waitcnt vmcnt(16)" ::: "memory"); else asm volatile("s_waitcnt vmcnt(8)" ::: "memory");
        f32x4 v[8], y[8];
#pragma unroll
        for (int j = 0; j < 8; ++j) v[j] = ((const LAS f32x4*)slot)[c.lane + 64 * j];
        if (i > 0) {
#pragma unroll
            for (int j = 0; j < 8; ++j) {
                if (R.smp) y[j] = ((const LAS f32x4*)(slot + 8192))[c.lane + 64 * j];
                else { const u32x2 yw = ((const LAS u32x2*)(slot + 8192))[c.lane + 64 * j]; y[j] = (f32x4){bflo(yw.x), bfhi(yw.x), bflo(yw.y), bfhi(yw.y)}; } }
        }
        asm volatile("s_waitcnt lgkmcnt(0)" ::: "memory");
        const int nrow = row + c.NGW;
        if (nrow < MROWS + NS) { const NormRow RN = norm_row_of(p, i, nrow); norm_dma_row(c, slot, RN, i > 0); }
        if (i > 0) {
            float ss = 0.f;
#pragma unroll
            for (int j = 0; j < 8; ++j) ss += (y[j].x * y[j].x + y[j].y * y[j].y) + (y[j].z * y[j].z + y[j].w * y[j].w);
            const float rstd = 1.0f / sqrtf(wave_sum(ss) * (1.0f / D) + RMS_EPS);
            const f32x4* gate = (const f32x4*)(MOD + (size_t)((i - 1) * 12 + R.mr) * 6144 + 4096); const f32x4* npo = (const f32x4*)(p.in[9] + (size_t)(i - 1) * D);
#pragma unroll
            for (int j = 0; j < 8; ++j) { const f32x4 g4 = gate[c.lane + 64 * j], n4 = npo[c.lane + 64 * j]; v[j] = v[j] + g4 * (y[j] * rstd * n4); ((f32x4*)R.xo)[c.lane + 64 * j] = v[j]; }
        }
        if (i < 4) {
            float ss = 0.f;
#pragma unroll
            for (int j = 0; j < 8; ++j) ss += (v[j].x * v[j].x + v[j].y * v[j].y) + (v[j].z * v[j].z + v[j].w * v[j].w);
            const float rstd = 1.0f / sqrtf(wave_sum(ss) * (1.0f / D) + RMS_EPS);
            const f32x4* sh = (const f32x4*)(MOD + (size_t)(i * 12 + R.mr) * 6144); const f32x4* sc = sh + 512; const f32x4* npr = (const f32x4*)(p.in[8] + (size_t)i * D);
            u32x2* ho = (u32x2*)R.h;
#pragma unroll
            for (int j = 0; j < 8; ++j) { const f32x4 s4 = sc[c.lane + 64 * j], h4 = sh[c.lane + 64 * j], n4 = npr[c.lane + 64 * j]; const f32x4 h = v[j] * rstd * n4 * (1.0f + s4) + h4;
                u32x2 w; w.x = pk2(h.x, h.y); w.y = pk2(h.z, h.w); ho[c.lane + 64 * j] = w; }
        }
    }
    asm volatile("s_waitcnt vmcnt(0)" ::: "memory");
}

__device__ __forceinline__ void w_acc(float (&S)[8], const u32x4 x, const float sgn) {
    S[0] += sgn * bflo(x.x); S[1] += sgn * bfhi(x.x); S[2] += sgn * bflo(x.y); S[3] += sgn * bfhi(x.y); S[4] += sgn * bflo(x.z); S[5] += sgn * bfhi(x.z); S[6] += sgn * bflo(x.w); S[7] += sgn * bfhi(x.w);
}
template <int W> __device__ __forceinline__ void window_task(const bf16* up  , bf16* ap, const float* scale, const int t0) {
    u32x4 ring[W]; float S[8];
#pragma unroll
    for (int e = 0; e < 8; ++e) S[e] = 0.f;
    ring[0] = (u32x4){0u, 0u, 0u, 0u};
#pragma unroll
    for (int r = 1; r < W; ++r) { if (t0 > 0) { ring[r] = *(const u32x4*)(up - (size_t)(W - r) * PIN); w_acc(S, ring[r], 1.0f); } else ring[r] = (u32x4){0u, 0u, 0u, 0u}; }
    const f32x4 s0 = *(const f32x4*)scale, s1 = *(const f32x4*)(scale + 4);
#pragma unroll
    for (int tt = 0; tt < 32; tt += W)
#pragma unroll
        for (int r = 0; r < W; ++r) {
            const int t = tt + r;
            const u32x4 x = *(const u32x4*)(up + (size_t)t * PIN), z = *(const u32x4*)(up + (size_t)t * PIN + PW);
            w_acc(S, x, 1.0f); w_acc(S, ring[r], -1.0f); ring[r] = x;
            const float inv = (t < W - 1 && t0 == 0) ? 1.0f / (float)(t + 1) : 1.0f / (float)W;
            u32x4 o;
            o.x = cvt_pk_bf16((S[0] * inv - bflo(x.x)) * s0.x * silu_f(bflo(z.x)), (S[1] * inv - bfhi(x.x)) * s0.y * silu_f(bfhi(z.x)));
            o.y = cvt_pk_bf16((S[2] * inv - bflo(x.y)) * s0.z * silu_f(bflo(z.y)), (S[3] * inv - bfhi(x.y)) * s0.w * silu_f(bfhi(z.y)));
            o.z = cvt_pk_bf16((S[4] * inv - bflo(x.z)) * s1.x * silu_f(bflo(z.z)), (S[5] * inv - bfhi(x.z)) * s1.y * silu_f(bfhi(z.z)));
            o.w = cvt_pk_bf16((S[6] * inv - bflo(x.w)) * s1.z * silu_f(bflo(z.w)), (S[7] * inv - bfhi(x.w)) * s1.w * silu_f(bfhi(z.w)));
            *(u32x4*)(ap + (size_t)t * PW) = o;
        }
}
__device__ __forceinline__ void phase_window(const Params& p, const Ctx& c, int li) {
    const bf16* proj = (const bf16*)(p.ws + WS_PROJ); bf16* A3 = (bf16*)(p.ws + WS_A3); const float* scale = p.in[15] + (size_t)li * PW;
    for (int task = c.vcu * NTH + c.tid; task < (MROWS / 32) * 512; task += c.G * NTH) {
        const int row0 = (task >> 9) * 32, col = (task & 511) * 8, g = col >> 10, t0 = row0 & (SEQ - 1);
        const bf16* up = proj + (size_t)row0 * PIN + col; bf16* ap = A3 + (size_t)row0 * PW + col;
        if (g == 0) window_task<2>(up, ap, scale + col, t0); else if (g == 1) window_task<4>(up, ap, scale + col, t0); else if (g == 2) window_task<8>(up, ap, scale + col, t0); else window_task<16>(up, ap, scale + col, t0);
    }
}

__device__ __forceinline__ void phase_attention_naive(const Params& p, const Ctx& c, int li) {
    const bf16* proj = (const bf16*)(p.ws + WS_PROJ); const float* BIAS = (const float*)(p.ws + WS_BIAS); bf16* A2 = (bf16*)(p.ws + WS_A3);
    LAS float* qs = (LAS float*)(c.lds + c.wave * 2048); LAS float* ps = qs + 128;
    for (int task = c.gw; task < MROWS * 16; task += c.NGW) {
        const int row = task >> 4, h = task & 15, t = row & (SEQ - 1);
        float og0[3], og1[3], lse[3];
#pragma unroll
        for (int g = 0; g < 3; ++g) {
            const int dil = 1 << (2 * g), nk = (t / dil) < 128 ? (t / dil) : 128;
            { const unsigned qw = *(const unsigned*)(proj + (size_t)row * AIN + g * 2048 + h * 128 + 2 * c.lane); qs[2 * c.lane] = bflo(qw); qs[2 * c.lane + 1] = bfhi(qw); }
            asm volatile("s_waitcnt lgkmcnt(0)" ::: "memory");
            float s[3], pj[3];
#pragma unroll
            for (int jj = 0; jj < 3; ++jj) {
                const int j = c.lane + 64 * jj; const bool valid = (jj < 2 || c.lane == 0) && j <= nk; float sc = NEG_INF;
                if (valid) { const bf16* kp = proj + (size_t)(row - j * dil) * AIN + QKVW + g * 2048 + h * 128; float dot = 0.f;
#pragma unroll
                    for (int ch = 0; ch < 16; ++ch) { const u32x4 kv = *(const u32x4*)(kp + 8 * ch); const f32x4 q0 = *(const LAS f32x4*)(qs + 8 * ch), q1 = *(const LAS f32x4*)(qs + 8 * ch + 4);
                        dot += (bflo(kv.x) * q0.x + bfhi(kv.x) * q0.y) + (bflo(kv.y) * q0.z + bfhi(kv.y) * q0.w) + (bflo(kv.z) * q1.x + bfhi(kv.z) * q1.y) + (bflo(kv.w) * q1.z + bfhi(kv.w) * q1.w); }
                    sc = dot * ATT_SCALE + BIAS[(g * 16 + h) * 132 + j]; }
                s[jj] = sc;
            }
            const float m = wave_max(fmaxf(fmaxf(s[0], s[1]), s[2]));
            float lsum = 0.f;
#pragma unroll
            for (int jj = 0; jj < 3; ++jj) { const int j = c.lane + 64 * jj; const bool valid = (jj < 2 || c.lane == 0) && j <= nk; pj[jj] = valid ? __expf(s[jj] - m) : 0.f; lsum += pj[jj]; if (jj < 2 || c.lane == 0) ps[j] = pj[jj]; }
            const float l = wave_sum(lsum);
            asm volatile("s_waitcnt lgkmcnt(0)" ::: "memory");
            float o0 = 0.f, o1 = 0.f;
            for (int j = 0; j <= nk; ++j) { const float pv = ps[j]; const unsigned vw = *(const unsigned*)(proj + (size_t)(row - j * dil) * AIN + 2 * QKVW + g * 2048 + h * 128 + 2 * c.lane); o0 += pv * bflo(vw); o1 += pv * bfhi(vw); }
            og0[g] = o0 / l; og1[g] = o1 / l; lse[g] = m + __logf(l);
            asm volatile("s_waitcnt lgkmcnt(0)" ::: "memory");
        }
        const float mm = fmaxf(fmaxf(lse[0], lse[1]), lse[2]); const float w0 = __expf(lse[0] - mm), w1 = __expf(lse[1] - mm), w2 = __expf(lse[2] - mm), wi = 1.0f / (w0 + w1 + w2);
        const unsigned zw = *(const unsigned*)(proj + (size_t)row * AIN + 3 * QKVW + h * 128 + 2 * c.lane);
        const float r0 = (w0 * og0[0] + w1 * og0[1] + w2 * og0[2]) * wi * silu_f(bflo(zw)), r1 = (w0 * og1[0] + w1 * og1[1] + w2 * og1[2]) * wi * silu_f(bfhi(zw));
        *(unsigned*)(A2 + (size_t)row * D + h * 128 + 2 * c.lane) = pk2(r0, r1);
    }
}
__device__ __forceinline__ void phase_attention_sample(const Params& p, const Ctx& c, int li) {
    const float* PS = (const float*)(p.ws + WS_PS); const float* BIAS = (const float*)(p.ws + WS_BIAS);
    float* OGS = (float*)(p.ws + WS_OGS); float* LSES = (float*)(p.ws + WS_LSES);
    const int grp = c.lane >> 4, l16 = c.lane & 15;
    for (int task = c.gw; task < NS * 3 * 16 * 4; task += c.NGW) {
        const int ks = task & 3, h = (task >> 2) & 15, g = (task >> 6) % 3, b = task / 192;
        const int dil = 1 << (2 * g), L = 128 << (2 * g), j0 = 33 * ks, j1 = (j0 + 33) < 129 ? (j0 + 33) : 129;
        const float* const ck0 = p.in[4]; const float* const ck1 = p.in[5]; const float* const ck2 = p.in[6];
        const float* cache = (g == 0 ? ck0 : (g == 1 ? ck1 : ck2)) + ((size_t)(li * NS + b) * L) * 4096 + h * 128;
        const float* pk0 = PS + (size_t)b * AIN + QKVW + g * 2048 + h * 128; const float* pv0 = pk0 + QKVW;
        const float* qp = PS + (size_t)b * AIN + g * 2048 + h * 128 + 8 * l16;
        const f32x4 q0 = *(const f32x4*)qp, q1 = *(const f32x4*)(qp + 4);
        float sc[9];
#pragma unroll
        for (int it = 0; it < 9; ++it) {
            const int j = j0 + 4 * it + grp; float dot = 0.f;
            if (j < j1) { const float* kp = (j == 0 ? pk0 : cache + (size_t)(L - j * dil) * 4096) + 8 * l16; const f32x4 k0 = *(const f32x4*)kp, k1 = *(const f32x4*)(kp + 4);
                dot = (k0.x * q0.x + k0.y * q0.y) + (k0.z * q0.z + k0.w * q0.w) + (k1.x * q1.x + k1.y * q1.y) + (k1.z * q1.z + k1.w * q1.w); }
            dot += __shfl_xor(dot, 1); dot += __shfl_xor(dot, 2); dot += __shfl_xor(dot, 4); dot += __shfl_xor(dot, 8);
            sc[it] = (j < j1) ? dot * ATT_SCALE + BIAS[(g * 16 + h) * 132 + j] : NEG_INF;
        }
        float m = sc[0];
#pragma unroll
        for (int it = 1; it < 9; ++it) m = fmaxf(m, sc[it]);
        m = fmaxf(m, __shfl_xor(m, 16)); m = fmaxf(m, __shfl_xor(m, 32));
        float lsum = 0.f;
#pragma unroll
        for (int it = 0; it < 9; ++it) { const int j = j0 + 4 * it + grp; sc[it] = (j < j1) ? __expf(sc[it] - m) : 0.f; lsum += sc[it]; }
        lsum += __shfl_xor(lsum, 16); lsum += __shfl_xor(lsum, 32);
        LAS float* ps = (LAS float*)(c.lds + c.wave * 256);
#pragma unroll
        for (int it = 0; it < 9; ++it) if (l16 == 0) ps[4 * it + grp] = sc[it];
        asm volatile("s_waitcnt lgkmcnt(0)" ::: "memory");
        float o0 = 0.f, o1 = 0.f;
        f32x2 vv[33];
#pragma unroll
        for (int jj = 0; jj < 33; ++jj) { const int j = j0 + jj, jc = j < j1 ? j : j1 - 1; const float* vp = (jc == 0 ? pv0 : cache + (size_t)(L - jc * dil) * 4096 + 2048) + 2 * c.lane; vv[jj] = *(const f32x2*)vp; }
#pragma unroll
        for (int jj = 0; jj < 33; ++jj) { const float pj = (j0 + jj < j1) ? ps[jj] : 0.f; o0 += pj * vv[jj].x; o1 += pj * vv[jj].y; }
        asm volatile("s_waitcnt lgkmcnt(0)" ::: "memory");
        const float inv = 1.0f / lsum; const int part = g * 4 + ks;
        *(f32x2*)(OGS + ((size_t)(b * 12 + part)) * D + h * 128 + 2 * c.lane) = (f32x2){o0 * inv, o1 * inv};
        if (c.lane == 0) LSES[(b * 12 + part) * 16 + h] = m + __logf(lsum);
    }
}
__device__ __forceinline__ void phase_combine_sample(const Params& p, const Ctx& c) {
    const float* PS = (const float*)(p.ws + WS_PS); const float* OGS = (const float*)(p.ws + WS_OGS); const float* LSES = (const float*)(p.ws + WS_LSES); bf16* A2S = (bf16*)(p.ws + WS_A3S);
    for (int o = c.vcu * NTH + c.tid; o < NS * D; o += c.G * NTH) {
        const int b = o >> 11, col = o & (D - 1), h = col >> 7;
        float ls[12], mm = NEG_INF;
#pragma unroll
        for (int k = 0; k < 12; ++k) { ls[k] = LSES[(b * 12 + k) * 16 + h]; mm = fmaxf(mm, ls[k]); }
        float ws = 0.f, acc = 0.f;
#pragma unroll
        for (int k = 0; k < 12; ++k) { const float wk = __expf(ls[k] - mm); ws += wk; acc += wk * OGS[((size_t)(b * 12 + k)) * D + col]; }
        A2S[(size_t)b * D + col] = (bf16)f2bf(acc / ws * silu_f(PS[(size_t)b * AIN + 3 * QKVW + col]));
    }
}

typedef float f32x16 __attribute__((ext_vector_type(16)));
typedef short v4i16_t __attribute__((ext_vector_type(4)));
constexpr int ATT_TAB_OFF = RING_BYTES + 1024;
__device__ __forceinline__ unsigned att_off(unsigned row, unsigned ch) { return 256u * row + 16u * (ch ^ (((row & 3u) << 2) | ((row >> 2) & 3u))); }
__device__ __forceinline__ void att_stage(const Ctx& c, const bf16* src_base  , int b, int g, int u) {
    const int rin = c.lane >> 4, slot = c.lane & 15, dil = 1 << (2 * g);
    const int i00 = g == 0 ? 256 * u : (g == 1 ? 256 * (u & 1) : 0);
    const bool skip_lo = (g == 2) || (i00 == 0);
#pragma unroll
    for (int i = 0; i < 12; ++i) {
        const int R4 = 48 * c.wave + 4 * i;
        if (skip_lo && R4 < 128) continue;
        const int R = R4 + rin;
        int res, sub;
        if (g == 2) { res = 2 * u + (R >= 256 ? 1 : 0); sub = R - (R >= 256 ? 256 : 128); }
        else { res = g == 0 ? 0 : (u >> 1); sub = i00 - 128 + R; }
        const int ch = slot ^ ((rin << 2) | (i & 3));
        __builtin_amdgcn_global_load_lds((const unsigned*)(src_base + (size_t)(b * SEQ + sub * dil + res) * AIN + ch * 8), (LAS unsigned*)(c.lds + R4 * 256), 16, 0, 0);
    }
}
__device__ __forceinline__ void phase_attention(const Params& p, const Ctx& c, int li) {
    const bf16* proj = (const bf16*)(p.ws + WS_PROJ); const float* BIAS = (const float*)(p.ws + WS_BIAS);
    bf16* OG = (bf16*)(p.ws + WS_OG); float* LSE = (float*)(p.ws + WS_LSE);
    LAS float* tab = (LAS float*)(c.lds + ATT_TAB_OFF);
    const int w = c.wave, seg = w >> 2, a = w & 3, lane = c.lane, q = lane & 31, hh = lane >> 5;
    unsigned kb[8], vb[4][2];
    { const unsigned krow = (unsigned)(seg * 128 + 32 * a + q);
#pragma unroll
      for (int s = 0; s < 8; ++s) kb[s] = att_off(krow, 2 * s + hh);
      const unsigned qq = (lane & 15) >> 2, pp = lane & 3, blk = (lane >> 4) & 1, vrow = (unsigned)(seg * 128 + 32 * a) + 4 * hh + qq;
#pragma unroll
      for (int dt = 0; dt < 4; ++dt)
#pragma unroll
          for (int t = 0; t < 2; ++t) vb[dt][t] = att_off(vrow + 8 * t, 4 * dt + 2 * blk + (pp >> 1)) + 8 * (pp & 1); }
    const LAS float* tl = tab + (32 + 4 * hh - q);
    for (int unit = c.vcu; unit < 1536; unit += c.G) {
        const int u = unit & 7, h = (unit >> 3) & 15, g = (unit >> 7) % 3, b = unit / 384, dil = 1 << (2 * g);
        int res, i0;
        if (g == 0) { res = 0; i0 = 256 * u + 128 * seg; }
        else if (g == 1) { res = u >> 1; i0 = 256 * (u & 1) + 128 * seg; }
        else { res = 2 * u + seg; i0 = 0; }
        const int kt_lo = (i0 == 0) ? 4 - a : 0;
        __syncthreads();
        att_stage(c, proj + QKVW + g * 2048 + h * 128, b, g, u);
        if (c.tid < 192) { const int x = c.tid; tab[x] = (x >= 32 && x <= 160) ? BIAS[(g * 16 + h) * 132 + (160 - x)] : NEG_INF; }
        const size_t qrow = (size_t)b * SEQ + (size_t)(i0 + 32 * a + q) * dil + res;
        bf16x8 qf[8];
#pragma unroll
        for (int s = 0; s < 8; ++s) qf[s] = *(const bf16x8*)(proj + qrow * AIN + g * 2048 + h * 128 + 16 * s + 8 * hh);
        asm volatile("s_waitcnt vmcnt(0) lgkmcnt(0)" ::: "memory");
        __syncthreads();
        f32x16 S[5];
        float mx = NEG_INF;
#pragma unroll
        for (int kt = 0; kt < 5; ++kt) {
            if (kt >= kt_lo) {
                f32x16 acc;
#pragma unroll
                for (int e = 0; e < 16; ++e) acc[e] = 0.f;
#pragma unroll
                for (int s = 0; s < 8; ++s) { const bf16x8 kf = *(const LAS bf16x8*)(c.lds + kb[s] + 8192 * kt); acc = __builtin_amdgcn_mfma_f32_32x32x16_bf16(kf, qf[s], acc, 0, 0, 0); }
#pragma unroll
                for (int e = 0; e < 16; ++e) { acc[e] = acc[e] * ATT_SCALE + tl[32 * kt + 8 * (e >> 2) + (e & 3)]; mx = fmaxf(mx, acc[e]); }
                S[kt] = acc;
            } else {
#pragma unroll
                for (int e = 0; e < 16; ++e) S[kt][e] = NEG_INF;
            }
            __builtin_amdgcn_sched_barrier(0);
        }
        mx = fmaxf(mx, __shfl_xor(mx, 32));
        float lsum = 0.f; bf16x8 pf[5][2];
#pragma unroll
        for (int kt = 0; kt < 5; ++kt) {
            float pe[16];
#pragma unroll
            for (int e = 0; e < 16; ++e) { pe[e] = __expf(S[kt][e] - mx); lsum += pe[e]; }
#pragma unroll
            for (int s2 = 0; s2 < 2; ++s2) { u32x4 pk; pk.x = cvt_pk_bf16(pe[8 * s2 + 0], pe[8 * s2 + 1]); pk.y = cvt_pk_bf16(pe[8 * s2 + 2], pe[8 * s2 + 3]); pk.z = cvt_pk_bf16(pe[8 * s2 + 4], pe[8 * s2 + 5]); pk.w = cvt_pk_bf16(pe[8 * s2 + 6], pe[8 * s2 + 7]);
                pf[kt][s2] = __builtin_bit_cast(bf16x8, pk); }
            __builtin_amdgcn_sched_barrier(0);
        }
        lsum += __shfl_xor(lsum, 32);
        __syncthreads();
        att_stage(c, proj + 2 * QKVW + g * 2048 + h * 128, b, g, u);
        asm volatile("s_waitcnt vmcnt(0)" ::: "memory");
        __syncthreads();
        const float inv = 1.0f / lsum;
        bf16* orow = OG + (size_t)g * MROWS * D + qrow * D + h * 128 + 4 * hh;
#pragma unroll
        for (int dt = 0; dt < 4; ++dt) {
            f32x16 O;
#pragma unroll
            for (int e = 0; e < 16; ++e) O[e] = 0.f;
#pragma unroll
            for (int kt = 0; kt < 5; ++kt) {
                if (kt >= kt_lo) {
#pragma unroll
                    for (int s2 = 0; s2 < 2; ++s2) {
                        const v4i16_t v0 = __builtin_amdgcn_ds_read_tr16_b64_v4i16((LAS v4i16_t*)(c.lds + vb[dt][0] + 256 * (32 * kt + 16 * s2)));
                        const v4i16_t v1 = __builtin_amdgcn_ds_read_tr16_b64_v4i16((LAS v4i16_t*)(c.lds + vb[dt][1] + 256 * (32 * kt + 16 * s2)));
                        const bf16x8 vf = {v0[0], v0[1], v0[2], v0[3], v1[0], v1[1], v1[2], v1[3]};
                        O = __builtin_amdgcn_mfma_f32_32x32x16_bf16(vf, pf[kt][s2], O, 0, 0, 0);
                    }
                }
            }
#pragma unroll
            for (int i4 = 0; i4 < 4; ++i4) { u32x2 o; o.x = cvt_pk_bf16(O[4 * i4 + 0] * inv, O[4 * i4 + 1] * inv); o.y = cvt_pk_bf16(O[4 * i4 + 2] * inv, O[4 * i4 + 3] * inv);
                *(u32x2*)(orow + 32 * dt + 8 * i4) = o; }
            __builtin_amdgcn_sched_barrier(0);
        }
        if (hh == 0) LSE[((size_t)g * MROWS + qrow) * 16 + h] = mx + __logf(lsum);
    }
    __syncthreads();
}
__device__ __forceinline__ void phase_combine(const Params& p, const Ctx& c) {
    const bf16* proj = (const bf16*)(p.ws + WS_PROJ); const bf16* OG = (const bf16*)(p.ws + WS_OG); const float* LSE = (const float*)(p.ws + WS_LSE); bf16* A2 = (bf16*)(p.ws + WS_A3);
    for (int task = c.vcu * NTH + c.tid; task < MROWS * 256; task += c.G * NTH) {
        const int row = task >> 8, ch = task & 255, h = ch >> 4;
        const float l0 = LSE[(size_t)row * 16 + h], l1 = LSE[((size_t)MROWS + row) * 16 + h], l2 = LSE[((size_t)2 * MROWS + row) * 16 + h];
        const float mm = fmaxf(fmaxf(l0, l1), l2); float w0 = __expf(l0 - mm), w1 = __expf(l1 - mm), w2 = __expf(l2 - mm); const float wi = 1.0f / (w0 + w1 + w2); w0 *= wi; w1 *= wi; w2 *= wi;
        const u32x4 o0 = *(const u32x4*)(OG + (size_t)row * D + ch * 8), o1 = *(const u32x4*)(OG + ((size_t)MROWS + row) * D + ch * 8), o2 = *(const u32x4*)(OG + ((size_t)2 * MROWS + row) * D + ch * 8);
        const u32x4 z = *(const u32x4*)(proj + (size_t)row * AIN + 3 * QKVW + ch * 8);
        u32x4 r;
        r.x = pk2((w0 * bflo(o0.x) + w1 * bflo(o1.x) + w2 * bflo(o2.x)) * silu_f(bflo(z.x)), (w0 * bfhi(o0.x) + w1 * bfhi(o1.x) + w2 * bfhi(o2.x)) * silu_f(bfhi(z.x)));
        r.y = pk2((w0 * bflo(o0.y) + w1 * bflo(o1.y) + w2 * bflo(o2.y)) * silu_f(bflo(z.y)), (w0 * bfhi(o0.y) + w1 * bfhi(o1.y) + w2 * bfhi(o2.y)) * silu_f(bfhi(z.y)));
        r.z = pk2((w0 * bflo(o0.z) + w1 * bflo(o1.z) + w2 * bflo(o2.z)) * silu_f(bflo(z.z)), (w0 * bfhi(o0.z) + w1 * bfhi(o1.z) + w2 * bfhi(o2.z)) * silu_f(bfhi(z.z)));
        r.w = pk2((w0 * bflo(o0.w) + w1 * bflo(o1.w) + w2 * bflo(o2.w)) * silu_f(bflo(z.w)), (w0 * bfhi(o0.w) + w1 * bfhi(o1.w) + w2 * bfhi(o2.w)) * silu_f(bfhi(z.w)));
        *(u32x4*)(A2 + (size_t)row * D + ch * 8) = r;
    }
}

__global__ void __launch_bounds__(NTH, 2) mega_fwd(Params p) {
    extern __shared__ __attribute__((aligned(16))) unsigned char lds_raw[];
    Ctx c;
    c.lds = (LAS unsigned char*)lds_raw;
    c.tid = threadIdx.x; c.lane = c.tid & 63; c.wave = __builtin_amdgcn_readfirstlane(c.tid >> 6);
    c.G = gridDim.x; { const int bx = blockIdx.x; c.vcu = (c.G % 8 == 0) ? (bx % 8) * (c.G / 8) + bx / 8 : bx; }
    c.gw = c.vcu * NWAVES + c.wave; c.NGW = c.G * NWAVES;
    volatile LAS unsigned* MISC = (volatile LAS unsigned*)(c.lds + MISC_OFF);
    for (int u = c.tid; u < (LDS_BYTES - LDSCTL_OFF) / 4; u += NTH) ((LAS unsigned*)(c.lds + LDSCTL_OFF))[u] = 0u;
    __syncthreads();
    unsigned* ctl = (unsigned*)(p.ws + WS_CTL);
    XcdBarrier bar; bar.bar = ctl + CW_BAR; bar.x = 0; bar.st = nullptr;
    const int lo = p.ph_lo, hi = p.ph_hi;
    if (hi - lo > 1) bar = xcd_barrier_post(ctl + CW_BAR, MISC + 8);
#define IN(k) (lo <= (k) && (k) < hi)
#define SEAM(k) do { if (IN(k) && IN((k) + 1)) xcd_barrier(bar); } while (0)
#define PH_BEGIN() Params q = p; asm volatile("" : "+s"(q.ws), "+s"(q.out), "+v"(c.tid), "+v"(c.lane))
#define WSP(T, off) ((T*)(q.ws + (off)))
    if (IN(0)) { PH_BEGIN(); phase_prologue(q, c); }
    SEAM(0);
    if (IN(1)) {
        PH_BEGIN();
        run_gemm<1>(c, pg8::Gemm{WSP(const bf16, WS_WPG), WSP(const bf16, WS_WUN), 2 * PW, D, 1024, 1024, 0, PW, 1}, StWg1{WSP(bf16, WS_WG1)});
    }
    const Ctx c0 = c;
    for (int i = 0; i < 4; ++i) {
        const int ph = 2 + 5 * i, li = i >> 1;
        Ctx c = c0; asm volatile("" : "+v"(c.tid), "+v"(c.lane), "+s"(c.gw), "+s"(c.vcu), "+s"(c.wave));
        if (IN(ph)) { PH_BEGIN(); phase_norm(q, c, i); }
        SEAM(ph);
        if (!(i & 1)) {
            if (IN(ph + 1)) {
                PH_BEGIN();
                bf16* const H = WSP(bf16, WS_H); const bf16* Wg1 = WSP(const bf16, WS_WG1) + (size_t)li * PIN * D; const bf16* Wut = WSP(const bf16, WS_WUT) + (size_t)li * PW * D;
                float* const PS = WSP(float, WS_PS); bf16* const RS = WSP(bf16, WS_RS);
                const float* st0 = q.in[7] + (size_t)li * NS * 15 * PW; float* po0 = q.out + O_POOLS + (size_t)li * NS * 15 * PW;
                sgemm8<1, 8>(c, H + (size_t)MROWS * D, D, 0, Wut, PW, D, [&](int s, int n, float v) {
                    const int w = 2 << (n >> 10); const float* st = st0 + (size_t)s * 15 * PW + n; float* po = po0 + (size_t)s * 15 * PW + n; float sum = v;
                    for (int j = 16 - w; j < 15; ++j) sum += st[(size_t)j * PW];
                    for (int j = 0; j < 14; ++j) po[(size_t)j * PW] = st[(size_t)(j + 1) * PW];
                    po[(size_t)14 * PW] = v;
                    RS[(size_t)s * PW + n] = (bf16)f2bf(sum / (float)w - v); });
                sgemm8<1, 8>(c, H + (size_t)MROWS * D, D, 0, Wg1 + (size_t)PW * D, PW, D, [&](int s, int n, float v) { PS[(size_t)s * PIN + PW + n] = v; });
                ulast_gemm(c, H, Wut, q.out + O_POOLP + (size_t)li * 4 * 15 * PW);
                run_gemm<0>(c, pg8::Gemm{H, Wg1, MROWS, PIN, D, D, 0, D, 0}, StBf16{WSP(bf16, WS_PROJ), PIN});
            }
            SEAM(ph + 1);
            if (IN(ph + 2)) {
                PH_BEGIN();
                const float* scale = q.in[15] + (size_t)li * PW; float* const PS = WSP(float, WS_PS); bf16* const A3S = WSP(bf16, WS_A3S);
                sgemm8<1, 4>(c, WSP(const bf16, WS_RS), PW, 1024, WSP(const bf16, WS_WPG) + (size_t)li * PW * 1024, PW, 1024, [&](int s, int n, float v) { A3S[(size_t)s * PW + n] = (bf16)f2bf(v * scale[n] * silu_f(PS[(size_t)s * PIN + PW + n])); });
                phase_window(q, c, li);
            }
            SEAM(ph + 2);
            if (IN(ph + 4)) {
                PH_BEGIN();
                const bf16* Wpo = WSP(const bf16, WS_WPO) + (size_t)li * D * PW; float* const Y = WSP(float, WS_Y);
                sgemm8<1, 16>(c, WSP(const bf16, WS_A3S), PW, 0, Wpo, D, PW, [&](int s, int n, float v) { Y[(size_t)(MROWS + s) * D + n] = v; });
                run_gemm<2>(c, pg8::Gemm{WSP(const bf16, WS_A3), Wpo, MROWS, D, PW, PW, 0, PW, 0}, StBf16{WSP(bf16, WS_Y), D});
            }
            SEAM(ph + 4);
        } else {
            if (IN(ph + 1)) {
                PH_BEGIN();
                bf16* const H = WSP(bf16, WS_H); const bf16* Wai = WSP(const bf16, WS_WAI) + (size_t)li * AIN * D; float* const PS = WSP(float, WS_PS); float* const out = q.out;
                sgemm8<5, 8>(c, H + (size_t)MROWS * D, D, 0, Wai, AIN, D, [&](int s, int n, float v) {
                    PS[(size_t)s * AIN + n] = v;
                    if (n >= QKVW && n < 3 * QKVW) { int cc = n - QKVW; const int kv = cc >= QKVW ? 1 : 0; cc -= kv * QKVW; const int g = cc >> 11, he = cc & 2047;
                        const size_t base = g == 0 ? O_KV0S : (g == 1 ? O_KV1S : O_KV2S); out[base + (size_t)(li * NS + s) * 4096 + kv * 2048 + he] = v; } });
                run_gemm<3>(c, pg8::Gemm{H, Wai, MROWS, AIN, D, D, 0, D, 0}, StG1a{WSP(bf16, WS_PROJ), q.out, li});
            }
            SEAM(ph + 1);
            if (IN(ph + 2)) { PH_BEGIN(); phase_attention_sample(q, c, li); phase_attention(q, c, li); }
            SEAM(ph + 2);
            if (IN(ph + 3)) { PH_BEGIN(); phase_combine_sample(q, c); phase_combine(q, c); }
            SEAM(ph + 3);
            if (IN(ph + 4)) {
                PH_BEGIN();
                const bf16* Wao = WSP(const bf16, WS_WAO) + (size_t)li * D * D; float* const Y = WSP(float, WS_Y);
                sgemm8<1, 8>(c, WSP(const bf16, WS_A3S), D, 0, Wao, D, D, [&](int s, int n, float v) { Y[(size_t)(MROWS + s) * D + n] = v; });
                run_gemm<4>(c, pg8::Gemm{WSP(const bf16, WS_A3), Wao, MROWS, D, D, D, 0, D, 0}, StBf16{WSP(bf16, WS_Y), D});
            }
            SEAM(ph + 4);
        }
    }
    if (IN(22)) { Ctx c = c0; asm volatile("" : "+v"(c.tid), "+v"(c.lane), "+s"(c.gw), "+s"(c.vcu), "+s"(c.wave)); PH_BEGIN(); phase_norm(q, c, 4); }
#undef PH_BEGIN
#undef WSP
#undef IN
#undef SEAM
}

extern "C" void kernel_launch(void* const* d_in, const int* in_sizes, int n_in, void* d_out, int out_size, void* d_ws, size_t ws_size, hipStream_t stream) {
    static int grid = 0;
    if (grid == 0) {
        if (n_in != 19 || (size_t)out_size != O_END || ws_size < WS_END) { fprintf(stderr, "kernel_launch: unexpected shapes: n_in %d out %d ws %zu; nothing launched\n", n_in, out_size, ws_size); grid = -1; return; }
        int dev = 0, cus = 0, per_cu = 0;
        if (hipGetDevice(&dev) != hipSuccess || hipDeviceGetAttribute(&cus, hipDeviceAttributeMultiprocessorCount, dev) != hipSuccess) { fprintf(stderr, "kernel_launch: device query failed\n"); grid = -1; return; }
        if (hipFuncSetAttribute((const void*)mega_fwd, hipFuncAttributeMaxDynamicSharedMemorySize, LDS_BYTES) != hipSuccess) { fprintf(stderr, "kernel_launch: hipFuncSetAttribute failed\n"); grid = -1; return; }
        if (hipOccupancyMaxActiveBlocksPerMultiprocessor(&per_cu, (const void*)mega_fwd, NTH, LDS_BYTES) != hipSuccess || per_cu < 1) fprintf(stderr, "kernel_launch: occupancy query reports %d workgroups per CU\n", per_cu);
        (void)hipGetLastError();
        grid = cus < 256 ? cus : 256;
        if (grid != 256) fprintf(stderr, "kernel_launch: %d CUs: this kernel is sized for the 256 CUs of MI355X\n", cus);
    }
    if (grid < 0) return;
    if (hipMemsetAsync((char*)d_ws + WS_CTL, 0, CTL_ZERO_BYTES, stream) != hipSuccess) { fprintf(stderr, "kernel_launch: memset failed\n"); return; }
    Params p{};
    for (int i = 0; i < 19; ++i) p.in[i] = (const float*)d_in[i];
    p.out = (float*)d_out; p.ws = (unsigned char*)d_ws;
#if MK_ONE_LAUNCH
    p.ph_lo = 0; p.ph_hi = N_PHASES;
    hipLaunchKernelGGL(mega_fwd, dim3(grid), dim3(NTH), LDS_BYTES, stream, p);
#else
    for (int ph = 0; ph < N_PHASES; ++ph) {
        if (ph >= 2 && ph < 22 && ((ph - 2) % 5) == 3 && (MK_NAIVE_ATT || !(((ph - 2) / 5) & 1))) continue;
        p.ph_lo = ph; p.ph_hi = ph + 1;
        hipLaunchKernelGGL(mega_fwd, dim3(grid), dim3(NTH), LDS_BYTES, stream, p);
    }
#endif
    const hipError_t le = hipPeekAtLastError();
    if (le != hipSuccess) fprintf(stderr, "kernel_launch: launch failed: %s\n", hipGetErrorName(le));
}
```
